# Optimizing an MI355X kernel written in HIP

```python
import jax, jax.numpy as jnp
from jax import lax
import numpy as np

D_MODEL = 1024
BATCH = 2
SEQ = 8192
DEPTH = 4
DEC_BATCH = 32
DEC_SEQ = 32
PAST_LEN = 2048

CHUNK = 64
A_CHUNK = 128
D_A = D_MODEL // 2
A_HEADS = 4
A_HEAD_DIM = D_A // A_HEADS
D_B = D_MODEL // 2
B_HEADS = 8
B_HEAD_DIM = D_B // B_HEADS
B_CONV = 4
LRU_C = 8.0
D_C = D_MODEL
C_CONV = 3
D_FF = 4 * D_MODEL
N_EVEN = (DEPTH + 1) // 2
N_ODD = DEPTH // 2
D_IN_EVEN = 2 * D_A + 2 * D_B
EPS = 1e-6

kernel_name = "hybrid_gmlp_rglru_shortconv_stream_step"


def rmsnorm(x, g):
    xf = x.astype(jnp.float32)
    y = xf * lax.rsqrt(jnp.mean(xf * xf, axis=-1, keepdims=True) + EPS)
    return (y * g.astype(jnp.float32)).astype(x.dtype)


def causal_dwconv(x, buf, w):
    width = w.shape[0]
    T = x.shape[1]
    xf = jnp.concatenate([buf.astype(x.dtype), x], axis=1)
    y = w[0] * xf[:, 0:T]
    for k in range(1, width):
        y = y + w[k] * xf[:, k:k + T]
    return y, xf[:, -(width - 1):]


def spatial_gating(u, v, w_s, b_s):
    bsz, T, _ = v.shape
    L = min(T, A_CHUNK)
    n = T // L
    pos = jnp.arange(L)
    mask = (pos[None, :] // CHUNK) <= (pos[:, None] // CHUNK)
    w = jnp.where(mask[None], w_s[:, :L, :L], 0).astype(v.dtype)
    vc = v.reshape(bsz, n, L, A_HEADS, A_HEAD_DIM)
    s = jnp.einsum('hij,bnjhc->bnihc', w, vc) + b_s[:, :L].T[None, None, :, :, None].astype(v.dtype)
    return u * s.reshape(bsz, T, D_A)


def rg_lru(x, h0, wa, ba, wx, bx, lam):
    bsz, T, _ = x.shape
    xh = x.reshape(bsz, T, B_HEADS, B_HEAD_DIM)
    r = jax.nn.sigmoid((jnp.einsum('bthi,hij->bthj', xh, wa).reshape(bsz, T, D_B) + ba).astype(jnp.float32))
    ig = jax.nn.sigmoid((jnp.einsum('bthi,hij->bthj', xh, wx).reshape(bsz, T, D_B) + bx).astype(jnp.float32))
    log_a = -LRU_C * r * jax.nn.softplus(-lam.astype(jnp.float32))
    a = jnp.exp(log_a)
    bterm = jnp.sqrt(-jnp.expm1(2.0 * log_a)) * ig * x.astype(jnp.float32)

    def combine(p, q):
        a1, b1 = p
        a2, b2 = q
        return a1 * a2, a2 * b1 + b2

    a_cum, b_cum = lax.associative_scan(combine, (a, bterm), axis=1)
    h = b_cum + a_cum * h0.astype(jnp.float32)[:, None]
    return h.astype(x.dtype), h[:, -1].astype(x.dtype)


def mixer_even(h, conv_buf, h0, w_in, v_gain, w_s, b_s, conv_w, conv_b, wa, ba, wx, bx, lam, w_out):
    z = h @ w_in
    u, v, xb, gb = jnp.split(z, [D_A, 2 * D_A, 2 * D_A + D_B], axis=-1)
    u = jax.nn.gelu(u)
    v = rmsnorm(jax.nn.gelu(v), v_gain)
    a_out = spatial_gating(u, v, w_s, b_s)
    xc, new_buf = causal_dwconv(xb, conv_buf, conv_w)
    hr, h_last = rg_lru(xc + conv_b, h0, wa, ba, wx, bx, lam)
    b_out = hr * jax.nn.gelu(gb)
    out = jnp.concatenate([a_out, b_out], axis=-1) @ w_out
    return out, v, new_buf, h_last


def mixer_odd(h, conv_buf, w_in, conv_w, w_out):
    bg, cg, xv = jnp.split(h @ w_in, 3, axis=-1)
    y, new_buf = causal_dwconv(cg * xv, conv_buf, conv_w)
    return (bg * y) @ w_out, new_buf


def trunk(x, b_conv, b_h, c_conv, p):
    v_rows, b_conv_new, b_h_new, c_conv_new = [], [], [], []
    for l in range(DEPTH):
        hn = rmsnorm(x, p['norm_mix_pre'][l])
        if l % 2 == 0:
            e = l // 2
            m, v, bc, bh = mixer_even(hn, b_conv[e], b_h[e], p['w_in_even'][e], p['a_v_gain'][e],
                                      p['a_w_s'][e], p['a_b_s'][e], p['b_conv_w'][e], p['b_conv_b'][e],
                                      p['b_wa'][e], p['b_ba'][e], p['b_wx'][e], p['b_bx'][e],
                                      p['b_lambda'][e], p['w_out_even'][e])
            v_rows.append(v)
            b_conv_new.append(bc)
            b_h_new.append(bh)
        else:
            o = l // 2
            m, cc = mixer_odd(hn, c_conv[o], p['c_w_in'][o], p['c_conv_w'][o], p['c_w_out'][o])
            c_conv_new.append(cc)
        x = x + rmsnorm(m, p['norm_mix_post'][l])
        hn = rmsnorm(x, p['norm_ffn_pre'][l])
        f = jnp.square(jax.nn.relu(hn @ p['mlp_up'][l])) @ p['mlp_down'][l]
        x = x + rmsnorm(f, p['norm_ffn_post'][l])
    return x, jnp.stack(v_rows), jnp.stack(b_conv_new), jnp.stack(b_h_new), jnp.stack(c_conv_new)


def setup_inputs(seed: int = 0) -> dict:
    key = jax.random.key(seed)
    ks = jax.random.split(key, 32)
    nrm = lambda k, shape, s: jax.random.normal(k, shape, jnp.float32) * s
    gain = lambda k, shape: 1.0 + 0.05 * jax.random.normal(k, shape, jnp.float32)
    a_init = jax.random.uniform(ks[19], (N_EVEN, D_B), jnp.float32, 0.9, 0.999)
    return {
        'x_prompt': nrm(ks[0], (BATCH, SEQ, D_MODEL), 1.0),
        'x_sample': nrm(ks[1], (DEC_BATCH, DEC_SEQ, D_MODEL), 1.0),
        'cache_b_conv': nrm(ks[2], (N_EVEN, DEC_BATCH, B_CONV - 1, D_B), 1.0),
        'state_b_h': nrm(ks[3], (N_EVEN, DEC_BATCH, D_B), 0.5),
        'cache_c_conv': nrm(ks[4], (N_ODD, DEC_BATCH, C_CONV - 1, D_C), 1.0),
        'norm_mix_pre': gain(ks[5], (DEPTH, D_MODEL)),
        'norm_mix_post': gain(ks[6], (DEPTH, D_MODEL)),
        'norm_ffn_pre': gain(ks[7], (DEPTH, D_MODEL)),
        'norm_ffn_post': gain(ks[8], (DEPTH, D_MODEL)),
        'w_in_even': nrm(ks[9], (N_EVEN, D_MODEL, D_IN_EVEN), D_MODEL ** -0.5),
        'a_v_gain': gain(ks[10], (N_EVEN, D_A)),
        'a_w_s': nrm(ks[11], (N_EVEN, A_HEADS, A_CHUNK, A_CHUNK), A_CHUNK ** -0.5),
        'a_b_s': 1.0 + 0.1 * jax.random.normal(ks[12], (N_EVEN, A_HEADS, A_CHUNK), jnp.float32),
        'b_conv_w': nrm(ks[13], (N_EVEN, B_CONV, D_B), B_CONV ** -0.5),
        'b_conv_b': nrm(ks[14], (N_EVEN, D_B), 0.01),
        'b_wa': nrm(ks[15], (N_EVEN, B_HEADS, B_HEAD_DIM, B_HEAD_DIM), B_HEAD_DIM ** -0.5),
        'b_ba': nrm(ks[16], (N_EVEN, D_B), 0.1),
        'b_wx': nrm(ks[17], (N_EVEN, B_HEADS, B_HEAD_DIM, B_HEAD_DIM), B_HEAD_DIM ** -0.5),
        'b_bx': nrm(ks[18], (N_EVEN, D_B), 0.1),
        'b_lambda': jnp.log(a_init) - jnp.log1p(-a_init),
        'w_out_even': nrm(ks[20], (N_EVEN, D_A + D_B, D_MODEL), (D_A + D_B) ** -0.5),
        'c_w_in': nrm(ks[21], (N_ODD, D_MODEL, 3 * D_C), D_MODEL ** -0.5),
        'c_conv_w': nrm(ks[22], (N_ODD, C_CONV, D_C), C_CONV ** -0.5),
        'c_w_out': nrm(ks[23], (N_ODD, D_C, D_MODEL), D_C ** -0.5),
        'mlp_up': nrm(ks[24], (DEPTH, D_MODEL, D_FF), D_MODEL ** -0.5),
        'mlp_down': nrm(ks[25], (DEPTH, D_FF, D_MODEL), D_FF ** -0.5),
    }


def reference(x_prompt, x_sample, cache_b_conv, state_b_h, cache_c_conv,
              norm_mix_pre, norm_mix_post, norm_ffn_pre, norm_ffn_post,
              w_in_even, a_v_gain, a_w_s, a_b_s, b_conv_w, b_conv_b, b_wa, b_ba, b_wx, b_bx,
              b_lambda, w_out_even, c_w_in, c_conv_w, c_w_out, mlp_up, mlp_down):
    p = dict(norm_mix_pre=norm_mix_pre, norm_mix_post=norm_mix_post,
             norm_ffn_pre=norm_ffn_pre, norm_ffn_post=norm_ffn_post,
             w_in_even=w_in_even, a_v_gain=a_v_gain, a_w_s=a_w_s, a_b_s=a_b_s,
             b_conv_w=b_conv_w, b_conv_b=b_conv_b, b_wa=b_wa, b_ba=b_ba, b_wx=b_wx, b_bx=b_bx,
             b_lambda=b_lambda, w_out_even=w_out_even, c_w_in=c_w_in, c_conv_w=c_conv_w,
             c_w_out=c_w_out, mlp_up=mlp_up, mlp_down=mlp_down)
    dt = x_prompt.dtype
    zb = jnp.zeros((N_EVEN, BATCH, B_CONV - 1, D_B), dt)
    zh = jnp.zeros((N_EVEN, BATCH, D_B), dt)
    zc = jnp.zeros((N_ODD, BATCH, C_CONV - 1, D_C), dt)
    y_prompt, _, bconv_p, bh_p, cconv_p = trunk(x_prompt, zb, zh, zc, p)
    y_sample, v_s, bconv_s, bh_s, cconv_s = trunk(x_sample, cache_b_conv, state_b_h, cache_c_conv, p)
    return (y_prompt, y_sample, v_s, bconv_p, bh_p, cconv_p, bconv_s, bh_s, cconv_s)
```

```cpp
#include <hip/hip_runtime.h>
#include <hip/hip_cooperative_groups.h>
#include <cstdio>
#include <cstdint>
#ifndef PROBE
#define PROBE 0
#endif
namespace cg = cooperative_groups;
namespace pg8 {
#define PG8_LAS __attribute__((address_space(3)))
typedef unsigned short bf16_t;
typedef short bf16x8 __attribute__((ext_vector_type(8)));
typedef float f32x4 __attribute__((ext_vector_type(4)));
typedef unsigned u32x4 __attribute__((ext_vector_type(4)));
constexpr int BM = 256, BK = 64, HALF = 128, HTB = HALF * BK * 2  , STAGE_BYTES = 8 * HTB, NXCD = 8, WGM = 8;

__host__ __device__ __forceinline__ int lds_byte(int r, int c) { const int st = (r >> 4) * 2 + (c >> 5), rr = r & 15, cc = c & 31, ob = rr * 64 + cc * 2; return st * 1024 + (ob ^ (((ob >> 9) & 1) << 5)); }
__host__ __device__ __forceinline__ void stage_rc(int b, int& R, int& C) { const int st = b / 1024, sb = b % 1024, swz = sb ^ (((sb >> 9) & 1) << 5); R = (st >> 1) * 16 + swz / 64; C = (st & 1) * 32 + (swz % 64) / 2; }
__host__ __device__ __forceinline__ int perm32(int rho) { const int n = rho >> 4, i = rho & 15; return 8 * (i >> 2) + 4 * n + (i & 3); }

struct Unit { int pm, pn, kb, nt, part; };
struct Gemm { const bf16_t* A; const bf16_t* Bt; int M, N, K; };

struct StaticOrder {
    int nM, nN, nwg, G, c;
    __host__ __device__ void init(int M, int N, int G_, int c_) { nM = M / BM; nN = N / BM; nwg = nM * nN; G = G_; c = c_; }
    __host__ __device__ bool next(int i, Unit& u) const {
        const long L = (long)i * G + c; if (L >= nwg) return false;
        int wgid = (int)L; { const int q = nwg / NXCD, r = nwg % NXCD, xcd = wgid % NXCD, off = wgid / NXCD; wgid = (xcd < r ? xcd * (q + 1) : r * (q + 1) + (xcd - r) * q) + off; }
        const int nig = WGM * nN, gid = wgid / nig, fm = gid * WGM, gsz = (nM - fm) < WGM ? (nM - fm) : WGM;
        u.pm = fm + ((wgid % nig) % gsz); u.pn = (wgid % nig) / gsz; return true;
    }
    __device__ __forceinline__ void a_ready(const Unit&) const {}
    __device__ __forceinline__ void done(const Unit&) const {}
};

struct SplitOrder {
    int nN, G, c, n_prompt, n_total, S, nt_full, nt_split;
    __device__ void init(int N, int K, int G_, int c_, int S_) { nN = N / BM; G = G_; c = c_; S = S_; n_prompt = 64 * nN; n_total = n_prompt + 4 * nN * S; nt_full = K / BK; nt_split = nt_full / S; }
    __device__ bool next(int i, Unit& u) const {
        const int L = i * G + c; if (L >= n_total) return false;
        if (L < n_prompt) { int wgid = L; { const int q = n_prompt / NXCD, xcd = wgid % NXCD, off = wgid / NXCD; wgid = xcd * q + off; }
            const int nig = WGM * nN, gid = wgid / nig; u.pm = gid * WGM + ((wgid % nig) % WGM); u.pn = (wgid % nig) / WGM; u.kb = 0; u.nt = nt_full; u.part = -1; }
        else { const int q = L - n_prompt, p = q % S, r = q / S; u.pm = 64 + (r & 3); u.pn = r >> 2; u.kb = p * nt_split * BK * 2; u.nt = nt_split; u.part = (S > 1) ? p : -1; }
        return true;
    }
    __device__ __forceinline__ void a_ready(const Unit&) const {}
    __device__ __forceinline__ void done(const Unit&) const {}
};
typedef float f32x2 __attribute__((ext_vector_type(2)));
__device__ __forceinline__ unsigned cvt_pk_bf16(float lo, float hi) { unsigned r; asm("v_cvt_pk_bf16_f32 %0, %1, %2" : "=v"(r) : "v"(lo), "v"(hi)); return r; }
template <class Epi, class Sched, bool ALIGN_EPI = false, bool SP2 = false>
__device__ __forceinline__ void gemm_phase(PG8_LAS unsigned char* lds, const Gemm g, const Sched& S, const Epi& E) {
    int tid = threadIdx.x; asm volatile("" : "+v"(tid));
    const int wid = __builtin_amdgcn_readfirstlane(tid >> 6), lane = tid & 63, wr = wid >> 2, wc = wid & 3, fr = lane & 15, fq = lane >> 4;
    const int K = g.K;
    unsigned voffA[2], voffB[2];
#pragma unroll
    for (int i = 0; i < 2; ++i) { int R, C; stage_rc(tid * 16 + i * 8192, R, C); const int Rb = Epi::PERM ? ((R & ~31) + perm32(R & 31)) : R;
        voffA[i] = (unsigned)(R * K + C) * 2u; voffB[i] = (unsigned)(Rb * K + C) * 2u; }
    const size_t kstep = (size_t)(BK * 2);
    const size_t hstep = (size_t)HALF * K * 2;
    const size_t tstep = 2 * hstep;
    const unsigned ldsw = (unsigned)wid * 1024u;
    const int aoff = lds_byte(wr * 64 + fr, fq * 8), boff = lds_byte(wc * 32 + fr, fq * 8);
#define PG8_SA(b, h) (((b) * 2 + (h)) * HTB)
#define PG8_SB(b, h) ((4 + (b) * 2 + (h)) * HTB)
#define PG8_STAGE(bufoff, gbase, voff) do { _Pragma("unroll") for (int _i = 0; _i < 2; ++_i) \
        __builtin_amdgcn_global_load_lds((const unsigned*)((const char*)(gbase) + (voff)[_i]), (PG8_LAS unsigned*)(lds + (bufoff) + ldsw + _i * 8192), 16, 0, 0); } while (0)
#define PG8_LDA(dst, b, h) do { _Pragma("unroll") for (int m = 0; m < 4; ++m) _Pragma("unroll") for (int k = 0; k < 2; ++k) dst[m][k] = *(const PG8_LAS bf16x8*)(lds + PG8_SA(b, h) + aoff + m * 2048 + k * 1024); } while (0)
#define PG8_LDB(dst, b, h) do { _Pragma("unroll") for (int n = 0; n < 2; ++n) _Pragma("unroll") for (int k = 0; k < 2; ++k) dst[n][k] = *(const PG8_LAS bf16x8*)(lds + PG8_SB(b, h) + boff + n * 2048 + k * 1024); } while (0)
#define PG8_MMA(ai, bj, At, Bt) do { __builtin_amdgcn_s_setprio(1); _Pragma("unroll") for (int m = 0; m < 4; ++m) _Pragma("unroll") for (int n = 0; n < 2; ++n) _Pragma("unroll") for (int k = 0; k < 2; ++k) \
        acc[ai][bj][m][n] = __builtin_amdgcn_mfma_f32_16x16x32_bf16(Bt[n][k], At[m][k], acc[ai][bj][m][n], 0, 0, 0); __builtin_amdgcn_s_setprio(0); } while (0)
#define PG8_WAIT_V(n) asm volatile("s_waitcnt vmcnt(" #n ")" ::: "memory")
#define PG8_WAIT_L(n) asm volatile("s_waitcnt lgkmcnt(" #n ")" ::: "memory")
#define PG8_BAR __builtin_amdgcn_s_barrier()
#define PG8_SCHED __builtin_amdgcn_sched_barrier(0)
    Unit cur, nxt; int ui = 0;
    if (!S.next(0, cur)) return;
    f32x4 acc[2][2][4][2];
#pragma unroll
    for (int a = 0; a < 2; ++a)
#pragma unroll
        for (int b = 0; b < 2; ++b)
#pragma unroll
            for (int m = 0; m < 4; ++m)
#pragma unroll
                for (int n = 0; n < 2; ++n) acc[a][b][m][n] = (f32x4){0.f, 0.f, 0.f, 0.f};
    bf16x8 At[4][2], B0[2][2], B1[2][2];
    const char* cA = (const char*)g.A + (size_t)cur.pm * tstep + cur.kb; const char* cB = (const char*)g.Bt + (size_t)cur.pn * tstep + cur.kb;
    S.a_ready(cur);
    if constexpr (SP2) {
        PG8_STAGE(PG8_SB(0, 0), cB, voffB); PG8_STAGE(PG8_SB(0, 1), cB + hstep, voffB); PG8_STAGE(PG8_SA(0, 0), cA, voffA); PG8_STAGE(PG8_SA(0, 1), cA + hstep, voffA);
        if (wr == 1) PG8_BAR;
        PG8_WAIT_V(2); PG8_BAR;
        PG8_STAGE(PG8_SB(1, 0), cB + kstep, voffB); PG8_STAGE(PG8_SA(1, 0), cA + kstep, voffA); PG8_STAGE(PG8_SB(1, 1), cB + hstep + kstep, voffB);
        PG8_WAIT_V(6); PG8_BAR;
    } else {
        PG8_STAGE(PG8_SB(0, 0), cB, voffB); PG8_STAGE(PG8_SA(0, 0), cA, voffA); PG8_STAGE(PG8_SB(0, 1), cB + hstep, voffB); PG8_STAGE(PG8_SA(0, 1), cA + hstep, voffA);
        if (wr == 1) PG8_BAR;
        PG8_WAIT_V(4); PG8_BAR;
        PG8_STAGE(PG8_SB(1, 0), cB + kstep, voffB); PG8_STAGE(PG8_SA(1, 0), cA + kstep, voffA); PG8_STAGE(PG8_SB(1, 1), cB + hstep + kstep, voffB);
        PG8_WAIT_V(6); PG8_BAR;
    }
    for (;;) {
        const bool has_next = S.next(ui + 1, nxt);
        const char* nA = has_next ? (const char*)g.A + (size_t)nxt.pm * tstep + nxt.kb : cA; const char* nB = has_next ? (const char*)g.Bt + (size_t)nxt.pn * tstep + nxt.kb : cB;
        const int nt = cur.nt;
        for (int t = 0; t < nt; t += 2) {
            const bool last = (t == nt - 2);
            const char* a1 = cA + (size_t)(t + 1) * kstep;
            const char* a2 = last ? nA : cA + (size_t)(t + 2) * kstep; const char* b2 = last ? nB : cB + (size_t)(t + 2) * kstep;
            const char* a3 = a2 + kstep; const char* b3 = b2 + kstep;
            if (last && has_next) S.a_ready(nxt);
            if constexpr (SP2) {
            PG8_LDB(B0, 0, 0); PG8_LDB(B1, 0, 1); PG8_SCHED; PG8_LDA(At, 0, 0); PG8_STAGE(PG8_SA(1, 1), a1 + hstep, voffA);
            PG8_WAIT_V(8); PG8_WAIT_L(0); PG8_BAR; PG8_MMA(0, 0, At, B0); PG8_MMA(0, 1, At, B1); PG8_BAR; PG8_SCHED;
            PG8_LDA(At, 0, 1); PG8_STAGE(PG8_SB(0, 0), b2, voffB); PG8_STAGE(PG8_SB(0, 1), b2 + hstep, voffB); PG8_STAGE(PG8_SA(0, 0), a2, voffA);
            PG8_WAIT_V(8); PG8_WAIT_L(0); PG8_BAR; PG8_MMA(1, 0, At, B0); PG8_MMA(1, 1, At, B1); PG8_BAR; PG8_SCHED;
            PG8_LDB(B0, 1, 0); PG8_LDB(B1, 1, 1); PG8_SCHED; PG8_LDA(At, 1, 0); PG8_STAGE(PG8_SA(0, 1), a2 + hstep, voffA);
            PG8_WAIT_V(8); PG8_WAIT_L(0); PG8_BAR; PG8_MMA(0, 0, At, B0); PG8_MMA(0, 1, At, B1); PG8_BAR; PG8_SCHED;
            PG8_LDA(At, 1, 1); PG8_STAGE(PG8_SB(1, 0), b3, voffB); PG8_STAGE(PG8_SB(1, 1), b3 + hstep, voffB); PG8_STAGE(PG8_SA(1, 0), a3, voffA);
            PG8_WAIT_V(8); PG8_WAIT_L(0); PG8_BAR; PG8_MMA(1, 0, At, B0); PG8_MMA(1, 1, At, B1); PG8_BAR; PG8_SCHED;
            } else {
            PG8_LDB(B0, 0, 0); PG8_SCHED; PG8_LDA(At, 0, 0); PG8_STAGE(PG8_SA(1, 1), a1 + hstep, voffA);
            PG8_WAIT_L(8); PG8_BAR; PG8_WAIT_L(0); PG8_MMA(0, 0, At, B0); PG8_BAR; PG8_SCHED;
            PG8_LDB(B1, 0, 1); PG8_STAGE(PG8_SB(0, 0), b2, voffB);
            PG8_BAR; PG8_WAIT_L(0); PG8_MMA(0, 1, At, B1); PG8_BAR;
            PG8_LDA(At, 0, 1); PG8_STAGE(PG8_SA(0, 0), a2, voffA);
            PG8_BAR; PG8_WAIT_L(0); PG8_MMA(1, 0, At, B0); PG8_BAR; PG8_SCHED;
            PG8_STAGE(PG8_SB(0, 1), b2 + hstep, voffB);
            PG8_WAIT_V(6); PG8_BAR; PG8_MMA(1, 1, At, B1); PG8_BAR;
            PG8_LDB(B0, 1, 0); PG8_SCHED; PG8_LDA(At, 1, 0); PG8_STAGE(PG8_SA(0, 1), a2 + hstep, voffA);
            PG8_WAIT_L(8); PG8_BAR; PG8_WAIT_L(0); PG8_MMA(0, 0, At, B0); PG8_BAR; PG8_SCHED;
            PG8_LDB(B1, 1, 1); PG8_STAGE(PG8_SB(1, 0), b3, voffB);
            PG8_BAR; PG8_WAIT_L(0); PG8_MMA(0, 1, At, B1); PG8_BAR;
            PG8_LDA(At, 1, 1); PG8_STAGE(PG8_SA(1, 0), a3, voffA);
            PG8_BAR; PG8_WAIT_L(0); PG8_MMA(1, 0, At, B0); PG8_BAR; PG8_SCHED;
            PG8_STAGE(PG8_SB(1, 1), b3 + hstep, voffB);
            PG8_WAIT_V(6); PG8_BAR; PG8_MMA(1, 1, At, B1); PG8_BAR;
            }
        }
        if constexpr (ALIGN_EPI) { if (wr == 0) PG8_BAR; }
        if constexpr (!Epi::AFTER_DRAIN) { E(acc, cur, wr, wc, fr, fq); S.done(cur); }
        if (!has_next) break;
#pragma unroll
        for (int a = 0; a < 2; ++a)
#pragma unroll
            for (int b = 0; b < 2; ++b)
#pragma unroll
                for (int m = 0; m < 4; ++m)
#pragma unroll
                    for (int n = 0; n < 2; ++n) acc[a][b][m][n] = (f32x4){0.f, 0.f, 0.f, 0.f};
        cur = nxt; cA = nA; cB = nB; ++ui;
        if constexpr (ALIGN_EPI) { if (wr == 1) PG8_BAR; }
    }
    PG8_WAIT_V(0);
    if constexpr (!ALIGN_EPI) { if (wr == 0) PG8_BAR; }
    PG8_BAR;
    if constexpr (Epi::AFTER_DRAIN) { E.fused(acc, cur, wr, wc, fr, fq, lds, wid, lane); S.done(cur); }
#undef PG8_SA
#undef PG8_SB
#undef PG8_STAGE
#undef PG8_LDA
#undef PG8_LDB
#undef PG8_MMA
#undef PG8_WAIT_V
#undef PG8_WAIT_L
#undef PG8_BAR
#undef PG8_SCHED
}
}
namespace pg8 {
typedef unsigned u32x2 __attribute__((ext_vector_type(2)));
__device__ __forceinline__ float gelu_f(float x) {
    const float t = x * (1.5957691216057308f + 0.0713548162726f * x * x);
    return x * __builtin_amdgcn_rcpf(1.0f + __builtin_amdgcn_exp2f(-1.4426950408889634f * t));
}
__device__ __forceinline__ f32x4 gelu4(const f32x4 x) {
    const f32x4 t = x * (x * x * (-1.4426950408889634f * 0.0713548162726f) + (-1.4426950408889634f * 1.5957691216057308f));
    f32x4 r; r.x = __builtin_amdgcn_rcpf(1.0f + __builtin_amdgcn_exp2f(t.x)); r.y = __builtin_amdgcn_rcpf(1.0f + __builtin_amdgcn_exp2f(t.y));
    r.z = __builtin_amdgcn_rcpf(1.0f + __builtin_amdgcn_exp2f(t.z)); r.w = __builtin_amdgcn_rcpf(1.0f + __builtin_amdgcn_exp2f(t.w));
    return x * r;
}
__device__ __forceinline__ u32x4 pack8(const f32x4& v0, const f32x4& v1) { return (u32x4){cvt_pk_bf16(v0[0], v0[1]), cvt_pk_bf16(v0[2], v0[3]), cvt_pk_bf16(v1[0], v1[1]), cvt_pk_bf16(v1[2], v1[3])}; }
__device__ __forceinline__ u32x4 xpose16(const u32x4 o, int srclane) { return (u32x4){(unsigned)__shfl((int)o.x, srclane), (unsigned)__shfl((int)o.y, srclane), (unsigned)__shfl((int)o.z, srclane), (unsigned)__shfl((int)o.w, srclane)}; }
struct EpiMulti {
    static constexpr bool PERM = true, AFTER_DRAIN = false;
    int mode;
    bf16_t* O0; int ldc;
    bf16_t* P1; float* VSS; bf16_t* PART; const float* RS;
    __device__ __forceinline__ void operator()(const f32x4 (&acc)[2][2][4][2], const Unit& u, int wr, int wc, int fr, int fq) const {
        const int row0 = u.pm * BM + wr * 64 + fr;
        const int lane_ = fq * 16 + fr, sl = (lane_ & 3) * 16 + (lane_ >> 2), r2 = lane_ >> 2, p2 = lane_ & 3, rowT = u.pm * BM + wr * 64 + r2;
        float rsv[2][4];
#pragma unroll
        for (int ai = 0; ai < 2; ++ai)
#pragma unroll
            for (int m = 0; m < 4; ++m) rsv[ai][m] = (mode != 0) ? RS[row0 + ai * HALF + m * 16] : 1.0f;
        if (mode == 0 || mode == 1 || (mode == 3 && u.pn < 4)) {
            const int col0 = u.pn * BM + wc * 32 + 8 * p2;
            bf16_t* const obase = (u.part >= 0) ? PART + ((size_t)u.part * 1024 - 16384) * 1024 : O0;
#pragma unroll
            for (int ai = 0; ai < 2; ++ai)
#pragma unroll
                for (int m = 0; m < 4; ++m) { bf16_t* rowp = obase + (size_t)(rowT + ai * HALF + m * 16) * ldc + col0;
                    const float rs = rsv[ai][m];
#pragma unroll
                    for (int bj = 0; bj < 2; ++bj) { f32x4 v0 = acc[ai][bj][m][0], v1 = acc[ai][bj][m][1];
                        if (mode == 1) { const f32x4 z = {0.f, 0.f, 0.f, 0.f}; v0 = __builtin_elementwise_max(v0 * rs, z); v1 = __builtin_elementwise_max(v1 * rs, z); v0 = v0 * v0; v1 = v1 * v1; }
                        else if (mode == 3) { v0 = v0 * rs; v1 = v1 * rs; }
                        *(u32x4*)(rowp + bj * HALF) = xpose16(pack8(v0, v1), sl); } }
        } else if (mode == 2) {
            const int kind = u.pn >> 1; bf16_t* dst = O0 + (size_t)kind * ((size_t)17408 * 512);
            const int col0 = (u.pn & 1) * 256 + wc * 32 + 8 * p2;
#pragma unroll
            for (int ai = 0; ai < 2; ++ai)
#pragma unroll
                for (int m = 0; m < 4; ++m) { const int row = row0 + ai * HALF + m * 16; bf16_t* rowp = dst + (size_t)(rowT + ai * HALF + m * 16) * 512 + col0; float ss = 0.f; const float rs = rsv[ai][m];
#pragma unroll
                    for (int bj = 0; bj < 2; ++bj) { f32x4 v0 = acc[ai][bj][m][0] * rs, v1 = acc[ai][bj][m][1] * rs;
                        if (kind == 1 || kind == 3) { v0 = gelu4(v0); v1 = gelu4(v1); const f32x4 q = v0 * v0 + v1 * v1; ss += (q.x + q.y) + (q.z + q.w); }
                        *(u32x4*)(rowp + bj * HALF) = xpose16(pack8(v0, v1), sl); }
                    if (kind == 1) { ss += __shfl_xor(ss, 16); ss += __shfl_xor(ss, 32); if (fq == 0) VSS[(size_t)row * 8 + (u.pn & 1) * 4 + wc] = ss; } }
        } else {
            const int col0 = (u.pn - 4) * 128 + wc * 32 + 8 * p2;
#pragma unroll
            for (int ai = 0; ai < 2; ++ai)
#pragma unroll
                for (int m = 0; m < 4; ++m) { bf16_t* rowp = P1 + (size_t)(rowT + ai * HALF + m * 16) * 1024 + col0; float rs = rsv[ai][m]; rs *= rs;
                    const f32x4 v0 = acc[ai][0][m][0] * acc[ai][1][m][0] * rs, v1 = acc[ai][0][m][1] * acc[ai][1][m][1] * rs;
                    *(u32x4*)rowp = xpose16(pack8(v0, v1), sl); }
        }
    }
};
}

#define LAS __attribute__((address_space(3)))
typedef unsigned short bf16_t;
typedef short bf16x8 __attribute__((ext_vector_type(8)));
typedef float f32x4 __attribute__((ext_vector_type(4)));
typedef unsigned u32x4 __attribute__((ext_vector_type(4)));
typedef unsigned u32x2 __attribute__((ext_vector_type(2)));
#define LDS_WAIT() asm volatile("s_waitcnt lgkmcnt(0)" ::: "memory")
using pg8::cvt_pk_bf16; using pg8::pack8; using pg8::gelu_f; using pg8::gelu4;

constexpr int M = 17408, MP = 16384, MS = 1024, D = 1024, FF = 4096;
constexpr float EPS = 1e-6f;
constexpr size_t MiB = 1u << 20;
constexpr size_t MT = (size_t)M * 1024 * 2;
constexpr size_t WS_WIN = 0, WS_WOUT = 6 * MiB, WS_WUP = 8 * MiB, WS_WDN = 16 * MiB;
constexpr size_t WS_SMALL = 24 * MiB;
constexpr size_t WS_WG = WS_SMALL, WS_GWA = WS_SMALL + 512 * 1024, WS_GWX = WS_SMALL + 640 * 1024, WS_SP = WS_SMALL + 768 * 1024;
constexpr size_t WS_BAS = WS_SP + 4096, WS_BXS = WS_SP + 8192;
constexpr size_t WS_AGGA = WS_SMALL + 1 * MiB, WS_AGGB = WS_SMALL + 2 * MiB + 128 * 1024, WS_VSS = WS_SMALL + 3 * MiB + 256 * 1024;
constexpr size_t WS_BAR = WS_SMALL + 3 * MiB + 832 * 1024;
constexpr size_t WS_RSTD = WS_SMALL + 3 * MiB + 896 * 1024;
constexpr size_t WS_HN = 28 * MiB, WS_BX = WS_HN + MT, WS_RA = WS_BX + MT, WS_END = WS_RA + 4 * MT;
constexpr size_t WS_PART = WS_END;
constexpr size_t WS_CARRY = WS_PART + 16 * MiB;
static_assert(WS_CARRY + 1 * MiB <= 256 * MiB, "workspace map");
constexpr int NCH32 = M / 32;
constexpr int LDS_BYTES = 147456;

struct Args { const float* in[26]; float* out; unsigned char* ws; int ph_lo, ph_hi; };

__device__ __forceinline__ float bflo(unsigned p) { return __builtin_bit_cast(float, p << 16); }
__device__ __forceinline__ float bfhi(unsigned p) { return __builtin_bit_cast(float, p & 0xffff0000u); }
__device__ __forceinline__ float bf2f(bf16_t b) { return __builtin_bit_cast(float, (unsigned)b << 16); }
__device__ __forceinline__ bf16_t f2bf(float f) { unsigned u = __builtin_bit_cast(unsigned, f); return (bf16_t)((u + 0x7fffu + ((u >> 16) & 1u)) >> 16); }
__device__ __forceinline__ float wave_sum(float v) {
#pragma unroll
    for (int o = 1; o < 64; o <<= 1) v += __shfl_xor(v, o);
    return v;
}
__device__ __forceinline__ float sigmoid_f(float x) { return __builtin_amdgcn_rcpf(1.0f + __builtin_amdgcn_exp2f(-1.4426950408889634f * x)); }
__device__ __forceinline__ float exp_f(float x) { return __builtin_amdgcn_exp2f(1.4426950408889634f * x); }

__device__ __forceinline__ const float* sel_ptr(bool c, const float* p, const float* q) { asm volatile("" : "+s"(p), "+s"(q)); return c ? p : q; }
__device__ __forceinline__ void transpose_item(const float* W, int N, int K, const float* gain, bf16_t* WT, int dst_n0, int src_n0, int k0, LAS float* scr, int lane) {
#pragma unroll 8
    for (int i = 0; i < 32; ++i) { const int kk = 2 * i + (lane >> 5); float v = __builtin_nontemporal_load(W + (size_t)(k0 + kk) * N + src_n0 + (lane & 31)); if (gain) v *= gain[k0 + kk]; scr[kk * 33 + (lane & 31)] = v; }
    LDS_WAIT();
    const int c = lane & 7;
#pragma unroll
    for (int j = 0; j < 4; ++j) { const int n = (lane >> 3) + 8 * j; const LAS float* s = scr + (8 * c) * 33 + n;
        u32x4 o; o.x = cvt_pk_bf16(s[0 * 33], s[1 * 33]); o.y = cvt_pk_bf16(s[2 * 33], s[3 * 33]); o.z = cvt_pk_bf16(s[4 * 33], s[5 * 33]); o.w = cvt_pk_bf16(s[6 * 33], s[7 * 33]);
        *(u32x4*)(WT + (size_t)(dst_n0 + n) * K + k0 + 8 * c) = o; }
    LDS_WAIT();
}
__device__ __forceinline__ void convert_weights(const Args& a, int l, int mask, LAS unsigned char* lds, int gw, int NGW, int wave, int lane) {
    LAS float* scr = (LAS float*)(lds + wave * 16384);
    const bool even = !(l & 1); const int e = l >> 1;
    const int Nin = even ? 2048 : 3072;
    const float* Win = sel_ptr(even, a.in[9], a.in[21]) + (size_t)e * 1024 * Nin;
    const float* Wout = sel_ptr(even, a.in[20], a.in[23]) + (size_t)e * 1024 * 1024;
    const float* Wup = a.in[24] + (size_t)l * 1024 * 4096; const float* Wdn = a.in[25] + (size_t)l * 4096 * 1024;
    const float* g_in = a.in[5] + l * 1024; const float* g_up = a.in[7] + l * 1024;
    bf16_t* WinT = (bf16_t*)(a.ws + WS_WIN); bf16_t* WoutT = (bf16_t*)(a.ws + WS_WOUT); bf16_t* WupT = (bf16_t*)(a.ws + WS_WUP); bf16_t* WdnT = (bf16_t*)(a.ws + WS_WDN);
    const int I_in = (mask & 1) ? 16 * (Nin / 32) : 0, I_out = (mask & 2) ? 16 * 32 : 0, I_up = (mask & 4) ? 16 * 128 : 0, I_dn = (mask & 8) ? 64 * 32 : 0, total = I_in + I_out + I_up + I_dn;
    for (int it = gw; it < total; it += NGW) {
        int r = it;
        if (r < I_in) { const int nblk = Nin / 32, kb = r / nblk, nb = r % nblk, d0 = 32 * nb; int s0 = d0;
            if (!even && d0 >= 1024) { const int q = d0 - 1024, p = q >> 8, b = (q >> 7) & 1, i = q & 127; s0 = 1024 + b * 1024 + 128 * p + i; }
            transpose_item(Win, Nin, 1024, g_in, WinT, d0, s0, 64 * kb, scr, lane); continue; }
        r -= I_in;
        if (r < I_out) { const int kb = r / 32, nb = r % 32; transpose_item(Wout, 1024, 1024, nullptr, WoutT, 32 * nb, 32 * nb, 64 * kb, scr, lane); continue; }
        r -= I_out;
        if (r < I_up) { const int kb = r / 128, nb = r % 128; transpose_item(Wup, 4096, 1024, g_up, WupT, 32 * nb, 32 * nb, 64 * kb, scr, lane); continue; }
        r -= I_up;
        { const int kb = r / 32, nb = r % 32; transpose_item(Wdn, 1024, 4096, nullptr, WdnT, 32 * nb, 32 * nb, 64 * kb, scr, lane); }
    }
}

__device__ __forceinline__ void phase_prologue(const Args& a, LAS unsigned char* lds, int gw, int NGW, int wave, int lane) {
    convert_weights(a, 0, 1, lds, gw, NGW, wave, lane);
    const int gt = gw * 64 + lane, GT = NGW * 64;
    bf16_t* WG = (bf16_t*)(a.ws + WS_WG); bf16_t* GWA = (bf16_t*)(a.ws + WS_GWA); bf16_t* GWX = (bf16_t*)(a.ws + WS_GWX); float* SP = (float*)(a.ws + WS_SP);
    for (int i = gt; i < 2 * 2 * 4 * 128 * 128; i += GT) {
        const int j = i & 127, ii = (i >> 7) & 127, h = (i >> 14) & 3, kind = (i >> 16) & 1, e = i >> 17;
        const float* w = a.in[11] + (size_t)(e * 4 + h) * 128 * 128; float v;
        if (kind == 0) v = ((j >> 6) <= (ii >> 6)) ? w[ii * 128 + j] : 0.f;
        else v = ((j >> 5) == (ii >> 5)) ? w[(ii & 31) * 128 + (j & 31)] : 0.f;
        WG[i] = f2bf(v);
    }
    for (int i = gt; i < 2 * 8 * 64 * 64; i += GT) {
        const int ii = i & 63, j = (i >> 6) & 63, eh = i >> 12;
        GWA[i] = f2bf(-1.4426950408889634f * a.in[15][(size_t)(eh * 64 + ii) * 64 + j]); GWX[i] = f2bf(-1.4426950408889634f * a.in[17][(size_t)(eh * 64 + ii) * 64 + j]);
    }
    for (int i = gt; i < 1024; i += GT) { const float nl = -a.in[19][i]; SP[i] = -8.0f * (fmaxf(nl, 0.f) + log1pf(expf(-fabsf(nl))));
        ((float*)(a.ws + WS_BAS))[i] = -1.4426950408889634f * a.in[16][i]; ((float*)(a.ws + WS_BXS))[i] = -1.4426950408889634f * a.in[18][i]; }
    bf16_t* X16 = (bf16_t*)(a.ws + WS_HN); float* RSTD = (float*)(a.ws + WS_RSTD);
    for (int m = gw; m < M; m += NGW) {
        const float* src = ((m < MP) ? a.in[0] + (size_t)m * D : a.in[1] + (size_t)(m - MP) * D) + 8 * lane;
        f32x4 v[4]; v[0] = __builtin_nontemporal_load((const f32x4*)src); v[1] = __builtin_nontemporal_load((const f32x4*)(src + 4)); v[2] = __builtin_nontemporal_load((const f32x4*)(src + 512)); v[3] = __builtin_nontemporal_load((const f32x4*)(src + 516));
        float ss = 0.f;
#pragma unroll
        for (int j = 0; j < 4; ++j) ss += (v[j].x * v[j].x + v[j].y * v[j].y) + (v[j].z * v[j].z + v[j].w * v[j].w);
        const float rstd = 1.0f / sqrtf(wave_sum(ss) * (1.f / D) + EPS);
        u32x4* ho = (u32x4*)(X16 + (size_t)m * D) + lane;
        ho[0] = pack8(v[0], v[1]); ho[64] = pack8(v[2], v[3]);
        if (lane == 0) RSTD[m] = rstd;
    }
}

__device__ __forceinline__ void up8(const u32x4 p, f32x4& a, f32x4& b) { a = (f32x4){bflo(p.x), bfhi(p.x), bflo(p.y), bfhi(p.y)}; b = (f32x4){bflo(p.z), bfhi(p.z), bflo(p.w), bfhi(p.w)}; }
__device__ __forceinline__ void phase_rows(const float* g, const bf16_t* MOb, const bf16_t* PART, int nsplit, bf16_t* X16, float* RSTD, float* Y, int gw, int NGW, int lane) {
    f32x4 gv[4];
    gv[0] = *(const f32x4*)(g + 8 * lane); gv[1] = *(const f32x4*)(g + 8 * lane + 4); gv[2] = *(const f32x4*)(g + 512 + 8 * lane); gv[3] = *(const f32x4*)(g + 512 + 8 * lane + 4);
    for (int m = gw; m < M; m += NGW) {
        u32x4* xr = (u32x4*)(X16 + (size_t)m * D) + lane;
        const u32x4 q0 = __builtin_nontemporal_load(xr), q1 = __builtin_nontemporal_load(xr + 64);
        f32x4 x[4], mo[4];
        if (m < MP) { const u32x4* mr = (const u32x4*)(MOb + (size_t)m * D) + lane; const u32x4 p0 = __builtin_nontemporal_load(mr), p1 = __builtin_nontemporal_load(mr + 64); up8(p0, mo[0], mo[1]); up8(p1, mo[2], mo[3]); }
        else {
#pragma unroll
            for (int j = 0; j < 4; ++j) mo[j] = (f32x4){0.f, 0.f, 0.f, 0.f};
            for (int sp = 0; sp < nsplit; ++sp) { const u32x4* mr = (const u32x4*)(PART + ((size_t)sp * 1024 + (m - MP)) * D) + lane; const u32x4 p0 = __builtin_nontemporal_load(mr), p1 = __builtin_nontemporal_load(mr + 64);
                f32x4 t0, t1, t2, t3; up8(p0, t0, t1); up8(p1, t2, t3); mo[0] += t0; mo[1] += t1; mo[2] += t2; mo[3] += t3; } }
        up8(q0, x[0], x[1]); up8(q1, x[2], x[3]);
        float ss = 0.f;
#pragma unroll
        for (int j = 0; j < 4; ++j) ss += (mo[j].x * mo[j].x + mo[j].y * mo[j].y) + (mo[j].z * mo[j].z + mo[j].w * mo[j].w);
        const float r1 = 1.0f / sqrtf(wave_sum(ss) * (1.f / D) + EPS); float s2 = 0.f;
#pragma unroll
        for (int j = 0; j < 4; ++j) { x[j] = x[j] + mo[j] * gv[j] * r1; s2 += (x[j].x * x[j].x + x[j].y * x[j].y) + (x[j].z * x[j].z + x[j].w * x[j].w); }
        if (Y) { float* yo = Y + (size_t)m * D + 8 * lane;
            *(f32x4*)yo = x[0]; *(f32x4*)(yo + 4) = x[1]; *(f32x4*)(yo + 512) = x[2]; *(f32x4*)(yo + 516) = x[3]; }
        else { const float r2 = 1.0f / sqrtf(wave_sum(s2) * (1.f / D) + EPS);
            xr[0] = pack8(x[0], x[1]); xr[64] = pack8(x[2], x[3]);
            if (lane == 0) RSTD[m] = r2; }
    }
}

__device__ __forceinline__ void unpack8(const u32x4 p, float (&v)[8]) { v[0] = bflo(p.x); v[1] = bfhi(p.x); v[2] = bflo(p.y); v[3] = bfhi(p.y); v[4] = bflo(p.z); v[5] = bfhi(p.z); v[6] = bflo(p.w); v[7] = bfhi(p.w); }
constexpr int VT_STRIDE = 136;
__device__ __forceinline__ void gating_item(const Args& a, int e, int item, float* vs_out, LAS unsigned char* lds, int tid, int wave, int lane) {
    const int tile = item >> 2, h = item & 3, row0 = tile * 128, kind = (tile >= 128) ? 1 : 0, fr = lane & 15, fq = lane >> 4;
    const bf16_t* U = (const bf16_t*)(a.ws + WS_RA); const bf16_t* GV = (const bf16_t*)(a.ws + WS_RA + MT / 2); const float* VSS = (const float*)(a.ws + WS_VSS);
    bf16_t* CAT = (bf16_t*)(a.ws + WS_BX);
    const float* gain = a.in[10] + e * 512 + h * 128;
    LAS bf16_t* Vt = (LAS bf16_t*)lds;
    u32x2 upre[8];
    { const int i = 16 * wave + fr, row = row0 + i;
#pragma unroll
      for (int c = 0; c < 8; ++c) upre[c] = __builtin_nontemporal_load((const u32x2*)(U + (size_t)row * 512 + h * 128 + 16 * c + 4 * fq)); }
    {
        const int j0 = 2 * lane, cw0 = 16 * wave; const size_t ra = (size_t)(row0 + j0), rb = ra + 1;
        const bf16_t* GV = (const bf16_t*)(a.ws + WS_RA + MT / 2); const float* VSS = (const float*)(a.ws + WS_VSS);
        const u32x4 ga0 = __builtin_nontemporal_load((const u32x4*)(GV + ra * 512 + h * 128 + cw0)), ga1 = __builtin_nontemporal_load((const u32x4*)(GV + ra * 512 + h * 128 + cw0 + 8));
        const u32x4 gb0 = __builtin_nontemporal_load((const u32x4*)(GV + rb * 512 + h * 128 + cw0)), gb1 = __builtin_nontemporal_load((const u32x4*)(GV + rb * 512 + h * 128 + cw0 + 8));
        const f32x4 pa0 = *(const f32x4*)(VSS + ra * 8), pa1 = *(const f32x4*)(VSS + ra * 8 + 4), pb0 = *(const f32x4*)(VSS + rb * 8), pb1 = *(const f32x4*)(VSS + rb * 8 + 4);
        const float rsa = 1.0f / sqrtf(((pa0.x + pa0.y) + (pa0.z + pa0.w) + (pa1.x + pa1.y) + (pa1.z + pa1.w)) * (1.f / 512.f) + EPS);
        const float rsb = 1.0f / sqrtf(((pb0.x + pb0.y) + (pb0.z + pb0.w) + (pb1.x + pb1.y) + (pb1.z + pb1.w)) * (1.f / 512.f) + EPS);
        float va[16], vb[16];
        { float t[8]; unpack8(ga0, t);
#pragma unroll
          for (int r = 0; r < 8; ++r) va[r] = t[r] * rsa;
          unpack8(ga1, t);
#pragma unroll
          for (int r = 0; r < 8; ++r) va[8 + r] = t[r] * rsa;
          unpack8(gb0, t);
#pragma unroll
          for (int r = 0; r < 8; ++r) vb[r] = t[r] * rsb;
          unpack8(gb1, t);
#pragma unroll
          for (int r = 0; r < 8; ++r) vb[8 + r] = t[r] * rsb; }
#pragma unroll
        for (int k = 0; k < 16; ++k) *(LAS unsigned*)(Vt + (cw0 + k) * VT_STRIDE + j0) = cvt_pk_bf16(va[k], vb[k]);
        if (kind) { float* oa = vs_out + (ra - MP) * 512 + h * 128 + cw0; float* ob = vs_out + (rb - MP) * 512 + h * 128 + cw0;
#pragma unroll
            for (int q = 0; q < 4; ++q) { const f32x4 g4 = *(const f32x4*)(gain + cw0 + 4 * q);
                *(f32x4*)(oa + 4 * q) = (f32x4){va[4 * q] * g4.x, va[4 * q + 1] * g4.y, va[4 * q + 2] * g4.z, va[4 * q + 3] * g4.w};
                *(f32x4*)(ob + 4 * q) = (f32x4){vb[4 * q] * g4.x, vb[4 * q + 1] * g4.y, vb[4 * q + 2] * g4.z, vb[4 * q + 3] * g4.w}; } }
    }
    __syncthreads();
    const bf16_t* WGp = (const bf16_t*)(a.ws + WS_WG) + (size_t)((e * 2 + kind) * 4 + h) * 128 * 128;
    const int ks_lo = kind ? (wave >> 1) : 0, ks_hi = kind ? (wave >> 1) + 1 : (wave < 4 ? 2 : 4);
    f32x4 acc[8];
#pragma unroll
    for (int c = 0; c < 8; ++c) acc[c] = (f32x4){0.f, 0.f, 0.f, 0.f};
#pragma unroll
    for (int ks = 0; ks < 4; ++ks) {
        if (ks >= ks_lo && ks < ks_hi) {
            const bf16x8 wg = *(const bf16x8*)(WGp + (size_t)(16 * wave + fr) * 128 + 32 * ks + 8 * fq);
#pragma unroll
            for (int c = 0; c < 8; ++c) { const bf16x8 vt = *(const LAS bf16x8*)(Vt + (16 * c + fr) * VT_STRIDE + 32 * ks + 8 * fq);
                acc[c] = __builtin_amdgcn_mfma_f32_16x16x32_bf16(vt, wg, acc[c], 0, 0, 0); }
        }
    }
    {
        const int i = 16 * wave + fr, row = row0 + i;
        const float bias = a.in[12][(size_t)(e * 4 + h) * 128 + (kind ? (i & 31) : i)];
#pragma unroll
        for (int c = 0; c < 8; ++c) { const int cc = 16 * c + 4 * fq; const f32x4 g4 = *(const f32x4*)(gain + cc);
            const u32x2 up = upre[c];
            const f32x4 ug = gelu4((f32x4){bflo(up.x), bfhi(up.x), bflo(up.y), bfhi(up.y)});
            const float o0 = ug.x * (acc[c][0] * g4.x + bias), o1 = ug.y * (acc[c][1] * g4.y + bias), o2 = ug.z * (acc[c][2] * g4.z + bias), o3 = ug.w * (acc[c][3] * g4.w + bias);
            *(u32x2*)(CAT + (size_t)row * 1024 + h * 128 + cc) = (u32x2){cvt_pk_bf16(o0, o1), cvt_pk_bf16(o2, o3)}; }
    }
    __syncthreads();
}
constexpr int XC_STRIDE = 68;
__device__ __forceinline__ void gates_item(const Args& a, int e, int tile64, LAS unsigned char* lds, int wave, int lane) {
    const int h = wave, c = 64 * h + lane, row0 = tile64 * 64, fr = lane & 15, fq = lane >> 4;
    const bf16_t* XB = (const bf16_t*)(a.ws + WS_RA + MT);
    unsigned* LB = (unsigned*)(a.ws + WS_RA + 2 * MT);
    LAS float* xcs = (LAS float*)(lds + wave * (64 * XC_STRIDE * 4));
    const float* cw = a.in[13] + (size_t)e * 4 * 512;
    const float w0 = cw[c], w1 = cw[512 + c], w2 = cw[1024 + c], w3 = cw[1536 + c], cb = a.in[14][e * 512 + c];
    float x0 = 0.f, x1 = 0.f, x2 = 0.f;
    {
        bf16_t xr[64];
#pragma unroll
        for (int i = 0; i < 64; ++i) xr[i] = __builtin_nontemporal_load(XB + (size_t)(row0 + i) * 512 + c);
        const int pos0 = (row0 < MP) ? (row0 & 8191) : ((row0 - MP) & 31);
        if (pos0 != 0) { x0 = bf2f(XB[(size_t)(row0 - 3) * 512 + c]); x1 = bf2f(XB[(size_t)(row0 - 2) * 512 + c]); x2 = bf2f(XB[(size_t)(row0 - 1) * 512 + c]); }
#pragma unroll
        for (int i = 0; i < 64; ++i) {
            if ((i & 31) == 0) {
                const int rowb = row0 + i, posb = (rowb < MP) ? (rowb & 8191) : ((rowb - MP) & 31);
                if (posb == 0) {
                    if (rowb < MP) { x0 = 0.f; x1 = 0.f; x2 = 0.f; }
                    else { const float* cbuf = a.in[2] + ((size_t)(e * 32 + ((rowb - MP) >> 5)) * 3) * 512 + c; x0 = cbuf[0]; x1 = cbuf[512]; x2 = cbuf[1024]; } } }
            const float xt = bf2f(xr[i]);
            xcs[i * XC_STRIDE + lane] = w0 * x0 + w1 * x1 + w2 * x2 + w3 * xt + cb;
            x0 = x1; x1 = x2; x2 = xt; }
    }
    LDS_WAIT();
    const bf16_t* GWA = (const bf16_t*)(a.ws + WS_GWA) + (size_t)(e * 8 + h) * 64 * 64; const bf16_t* GWX = (const bf16_t*)(a.ws + WS_GWX) + (size_t)(e * 8 + h) * 64 * 64;
    bf16x8 wa[4][2], wx[4][2];
#pragma unroll
    for (int n = 0; n < 4; ++n)
#pragma unroll
        for (int ks = 0; ks < 2; ++ks) { wa[n][ks] = *(const bf16x8*)(GWA + (16 * n + fr) * 64 + 32 * ks + 8 * fq); wx[n][ks] = *(const bf16x8*)(GWX + (16 * n + fr) * 64 + 32 * ks + 8 * fq); }
    const float* BA = (const float*)(a.ws + WS_BAS) + e * 512 + 64 * h; const float* BX_ = (const float*)(a.ws + WS_BXS) + e * 512 + 64 * h; const float* SP = (const float*)(a.ws + WS_SP) + e * 512 + 64 * h;
    for (int g = 0; g < 4; ++g) {
        bf16x8 xb[2];
#pragma unroll
        for (int ks = 0; ks < 2; ++ks) { const LAS float* p = xcs + (16 * g + fr) * XC_STRIDE + 32 * ks + 8 * fq; const f32x4 lo = *(const LAS f32x4*)p, hi = *(const LAS f32x4*)(p + 4);
            xb[ks] = __builtin_bit_cast(bf16x8, pack8(lo, hi)); }
        f32x4 aa[4], ax[4];
#pragma unroll
        for (int n = 0; n < 4; ++n) { aa[n] = (f32x4){0.f, 0.f, 0.f, 0.f}; ax[n] = (f32x4){0.f, 0.f, 0.f, 0.f};
#pragma unroll
            for (int ks = 0; ks < 2; ++ks) { aa[n] = __builtin_amdgcn_mfma_f32_16x16x32_bf16(wa[n][ks], xb[ks], aa[n], 0, 0, 0); ax[n] = __builtin_amdgcn_mfma_f32_16x16x32_bf16(wx[n][ks], xb[ks], ax[n], 0, 0, 0); } }
        u32x4 pk[4];
#pragma unroll
        for (int n = 0; n < 4; ++n) { const int cc = 16 * n + 4 * fq;
            const f32x4 xc4 = *(const LAS f32x4*)(xcs + (16 * g + fr) * XC_STRIDE + cc), ba4 = *(const f32x4*)(BA + cc), bx4 = *(const f32x4*)(BX_ + cc), sp4 = *(const f32x4*)(SP + cc);
            f32x4 la, bb;
#pragma unroll
            for (int r = 0; r < 4; ++r) { const float rg = __builtin_amdgcn_rcpf(1.0f + __builtin_amdgcn_exp2f(aa[n][r] + ba4[r])), ig = __builtin_amdgcn_rcpf(1.0f + __builtin_amdgcn_exp2f(ax[n][r] + bx4[r])); const float l = rg * sp4[r];
                const float w = (l > -0.03125f) ? -l * (1.0f + l * (0.5f + l * (0.16666667f + l * 0.041666668f))) : 1.0f - exp_f(l);
                const float om = w * (2.0f - w);
                la[r] = w; bb[r] = __builtin_amdgcn_sqrtf(fmaxf(om, 0.f)) * ig * xc4[r]; }
            pk[n] = (u32x4){cvt_pk_bf16(la[0], bb[0]), cvt_pk_bf16(la[1], bb[1]), cvt_pk_bf16(la[2], bb[2]), cvt_pk_bf16(la[3], bb[3])}; }
        LDS_WAIT();
#pragma unroll
        for (int n = 0; n < 4; ++n) *(LAS u32x4*)((LAS unsigned*)xcs + (16 * g + fr) * XC_STRIDE + 16 * n + 4 * fq) = pk[n];
    }
    LDS_WAIT();
    {
        float* AGGA = (float*)(a.ws + WS_AGGA); float* AGGB = (float*)(a.ws + WS_AGGB);
        float sa = 1.f, hh = 0.f;
#pragma unroll 8
        for (int t = 0; t < 64; ++t) { const unsigned p = ((const LAS unsigned*)xcs)[t * XC_STRIDE + lane]; __builtin_nontemporal_store(p, LB + (size_t)(row0 + t) * 512 + c);
            const float a_ = 1.0f - bflo(p); sa *= a_; hh = a_ * hh + bfhi(p);
            if ((t & 31) == 31) { const size_t ai = (size_t)((row0 >> 5) + (t >> 5)) * 512 + c; AGGA[ai] = sa; AGGB[ai] = hh; sa = 1.f; hh = 0.f; } }
    }
    LDS_WAIT();
}
__device__ __forceinline__ void phase_scan_agg(const Args& a, int gt, int GT) {
    const unsigned* LB = (const unsigned*)(a.ws + WS_RA + 2 * MT);
    float* AGGA = (float*)(a.ws + WS_AGGA); float* AGGB = (float*)(a.ws + WS_AGGB);
    for (int idx = gt; idx < NCH32 * 512; idx += GT) { const int ch = idx >> 9, c = idx & 511; const size_t base = (size_t)ch * 32 * 512 + c;
        float sl = 0.f, hh = 0.f;
#pragma unroll 8
        for (int t = 0; t < 32; ++t) { const unsigned p = LB[base + (size_t)t * 512]; const float l = bflo(p), b = bfhi(p); sl += l; hh = exp_f(l) * hh + b; }
        AGGA[idx] = sl; AGGB[idx] = hh; }
}
__device__ __forceinline__ void phase_scan_carry(const Args& a, int gw, int NGW, int lane) {
    const float* AGGA = (const float*)(a.ws + WS_AGGA); const float* AGGB = (const float*)(a.ws + WS_AGGB); float* CARRY = (float*)(a.ws + WS_CARRY);
    for (int task = gw; task < 1024; task += NGW) { const int b = task >> 9, c = task & 511; const size_t base = (size_t)(b * 256 + 4 * lane) * 512 + c;
        float ak[4], bk[4];
#pragma unroll
        for (int k = 0; k < 4; ++k) { ak[k] = AGGA[base + (size_t)k * 512]; bk[k] = AGGB[base + (size_t)k * 512]; }
        float ea[4], eb[4]; float A = 1.f, B = 0.f;
#pragma unroll
        for (int k = 0; k < 4; ++k) { ea[k] = A; eb[k] = B; B = ak[k] * B + bk[k]; A = ak[k] * A; }
#pragma unroll
        for (int d = 1; d < 64; d <<= 1) { const float pa = __shfl_up(A, d), pb = __shfl_up(B, d); if (lane >= d) { B = A * pb + B; A = A * pa; } }
        float Pb = __shfl_up(B, 1); if (lane == 0) Pb = 0.f;
#pragma unroll
        for (int k = 0; k < 4; ++k) CARRY[base + (size_t)k * 512] = ea[k] * Pb + eb[k];
    }
}
__device__ __forceinline__ void phase_scan_apply(const Args& a, int e, float* out_bconv_p, float* out_bh_p, float* out_bconv_s, float* out_bh_s, int gt, int GT) {
    const unsigned* LB = (const unsigned*)(a.ws + WS_RA + 2 * MT);
    const bf16_t* XB = (const bf16_t*)(a.ws + WS_RA + MT); const bf16_t* GG = (const bf16_t*)(a.ws + WS_RA + MT + MT / 2);
    const float* CARRY = (const float*)(a.ws + WS_CARRY);
    bf16_t* CAT = (bf16_t*)(a.ws + WS_BX);
    for (int idx = gt; idx < NCH32 * 512; idx += GT) { const int ch = idx >> 9, c = idx & 511; const size_t base = (size_t)ch * 32 * 512 + c;
        float hh;
        if (ch < 512) hh = CARRY[idx];
        else hh = a.in[3][(size_t)(e * 32 + (ch - 512)) * 512 + c];
        unsigned pw[32]; bf16_t gg[32];
#pragma unroll
        for (int t = 0; t < 32; ++t) { pw[t] = __builtin_nontemporal_load(LB + base + (size_t)t * 512); gg[t] = __builtin_nontemporal_load(GG + base + (size_t)t * 512); }
#pragma unroll
        for (int t = 0; t < 32; ++t) { const float a_ = 1.0f - bflo(pw[t]), b = bfhi(pw[t]); hh = a_ * hh + b;
            CAT[((size_t)ch * 32 + t) * 1024 + 512 + c] = f2bf(hh * bf2f(gg[t])); }
        const bool last = (ch >= 512) || ((ch & 255) == 255);
        if (last) { const size_t r0 = (size_t)ch * 32 + 29;
            if (ch < 512) { const int b = ch >> 8; out_bh_p[(e * 2 + b) * 512 + c] = hh;
#pragma unroll
                for (int j = 0; j < 3; ++j) out_bconv_p[((size_t)(e * 2 + b) * 3 + j) * 512 + c] = bf2f(XB[(r0 + j) * 512 + c]); }
            else { const int s = ch - 512; out_bh_s[(e * 32 + s) * 512 + c] = hh;
#pragma unroll
                for (int j = 0; j < 3; ++j) out_bconv_s[((size_t)(e * 32 + s) * 3 + j) * 512 + c] = bf2f(XB[(r0 + j) * 512 + c]); } }
    }
}
__device__ __forceinline__ void phase_conv_odd(const Args& a, int o, float* out_cc_p, float* out_cc_s, int gt, int GT) {
    const bf16_t* BG = (const bf16_t*)(a.ws + WS_RA); const bf16_t* T = (const bf16_t*)(a.ws + WS_RA + MT); bf16_t* A2 = (bf16_t*)(a.ws + WS_BX);
    const float* cw = a.in[22] + (size_t)o * 3 * 1024;
    constexpr int RB = 4;
    for (int idx = gt; idx < (M / RB) * 128; idx += GT) { const int rb = idx >> 7, c0 = (idx & 127) * 8, row0 = rb * RB; const int pos0 = (row0 < MP) ? (row0 & 8191) : ((row0 - MP) & 31);
        u32x4 tb[RB], bgb[RB];
#pragma unroll
        for (int i = 0; i < RB; ++i) { tb[i] = *(const u32x4*)(T + (size_t)(row0 + i) * 1024 + c0); bgb[i] = __builtin_nontemporal_load((const u32x4*)(BG + (size_t)(row0 + i) * 1024 + c0)); }
        float t1[8], t2[8];
        if (pos0 != 0) { unpack8(*(const u32x4*)(T + (size_t)(row0 - 1) * 1024 + c0), t1); unpack8(*(const u32x4*)(T + (size_t)(row0 - 2) * 1024 + c0), t2); }
        else if (row0 < MP) {
#pragma unroll
            for (int r = 0; r < 8; ++r) { t1[r] = 0.f; t2[r] = 0.f; } }
        else { const float* cbuf = a.in[4] + ((size_t)(o * 32 + ((row0 - MP) >> 5)) * 2) * 1024 + c0;
#pragma unroll
            for (int r = 0; r < 8; ++r) { t2[r] = cbuf[r]; t1[r] = cbuf[1024 + r]; } }
        float w0[8], w1[8], w2[8];
#pragma unroll
        for (int r = 0; r < 8; ++r) { w0[r] = cw[c0 + r]; w1[r] = cw[1024 + c0 + r]; w2[r] = cw[2048 + c0 + r]; }
#pragma unroll
        for (int i = 0; i < RB; ++i) { float t0[8], g[8], y[8]; unpack8(tb[i], t0); unpack8(bgb[i], g);
#pragma unroll
            for (int r = 0; r < 8; ++r) y[r] = g[r] * (w0[r] * t2[r] + w1[r] * t1[r] + w2[r] * t0[r]);
            *(u32x4*)(A2 + (size_t)(row0 + i) * 1024 + c0) = (u32x4){cvt_pk_bf16(y[0], y[1]), cvt_pk_bf16(y[2], y[3]), cvt_pk_bf16(y[4], y[5]), cvt_pk_bf16(y[6], y[7])};
#pragma unroll
            for (int r = 0; r < 8; ++r) { t2[r] = t1[r]; t1[r] = t0[r]; } }
        const int posl = pos0 + RB - 1;
        if (row0 < MP) { if (posl == 8191) { float* dst = out_cc_p + ((size_t)(o * 2 + (row0 >> 13)) * 2) * 1024 + c0;
#pragma unroll
                for (int r = 0; r < 8; ++r) { dst[r] = t2[r]; dst[1024 + r] = t1[r]; } } }
        else if (posl == 31) { float* dst = out_cc_s + ((size_t)(o * 32 + ((row0 - MP) >> 5)) * 2) * 1024 + c0;
#pragma unroll
            for (int r = 0; r < 8; ++r) { dst[r] = t2[r]; dst[1024 + r] = t1[r]; } }
    }
}

#define XB_TMO      128
#define XB_XCNT(j)  (256  + 64 * (j))
#define XB_XSUB(j)  (1280 + 64 * (j))
#define XB_XGEN(j)  (2304 + 64 * (j))
#define XB_TOP      3328
#define XB_TOPGEN   3392
#define XCD_BAR_WORDS 3456
#define XB_SPIN_CAP (1u << 18)

__device__ __forceinline__ unsigned xb_ld(unsigned* p)              { return __hip_atomic_load(p, __ATOMIC_RELAXED, __HIP_MEMORY_SCOPE_AGENT); }
__device__ __forceinline__ unsigned xb_add(unsigned* p, unsigned v) { return __hip_atomic_fetch_add(p, v, __ATOMIC_RELAXED, __HIP_MEMORY_SCOPE_AGENT); }
__device__ __forceinline__ unsigned xb_xcc_id() { return (unsigned)__builtin_amdgcn_s_getreg((3 << 11) | 20) & 0xFu; }
#define XB_SPIN(cond, bar) do { unsigned _sp = 0; while (cond) { __builtin_amdgcn_s_sleep(1); \
    if ((++_sp & 255u) == 0u) { if (xb_ld(&(bar)[XB_TMO])) break; if (_sp > XB_SPIN_CAP) { atomicAdd(&(bar)[XB_TMO], 1u); break; } } } } while (0)

struct XcdBarrier {
    unsigned* bar; unsigned x;
    volatile LAS unsigned* st;
};

__device__ __forceinline__ XcdBarrier xcd_barrier_post(unsigned* bar, volatile LAS unsigned* st) {
    XcdBarrier b; b.bar = bar; b.x = xb_xcc_id(); b.st = st;
    if (threadIdx.x == 0) (void)xb_add(&bar[XB_XCNT(b.x)], 1u);
    return b;
}
__device__ __forceinline__ void xcd_barrier_complete(unsigned* bar, unsigned x, unsigned& nloc, unsigned& nx) {
    const unsigned G = gridDim.x * gridDim.y * gridDim.z;
    unsigned sum, cnt, mine, sp = 0u;
    for (;;) {
        sum = 0u; cnt = 0u; mine = 0u;
#pragma unroll
        for (unsigned j = 0; j < 16; ++j) { const unsigned c = xb_ld(&bar[XB_XCNT(j)]); sum += c; cnt += (c > 0u) ? 1u : 0u; mine = (j == x) ? c : mine; }
        if (sum == G) break;
        __builtin_amdgcn_s_sleep(1);
        if ((++sp & 255u) == 0u) { if (xb_ld(&bar[XB_TMO])) break; if (sp > XB_SPIN_CAP) { atomicAdd(&bar[XB_TMO], 1u); break; } }
    }
    nloc = mine > 0u ? mine : 1u; nx = cnt > 0u ? cnt : 1u;
}

__device__ __forceinline__ void xcd_barrier(const XcdBarrier& b) {
    asm volatile("s_waitcnt vmcnt(0)" ::: "memory");
    __syncthreads();
    if (threadIdx.x == 0) {
        unsigned* bar = b.bar;
        __builtin_amdgcn_s_waitcnt(0);
        unsigned nloc = b.st[0], nx = b.st[1];
        if (nloc == 0u) { xcd_barrier_complete(bar, b.x, nloc, nx); b.st[0] = nloc; b.st[1] = nx; }
        const unsigned old = xb_add(&bar[XB_XSUB(b.x)], 1u);
        const unsigned gen = old / nloc;
        if (old + 1u == (gen + 1u) * nloc) {
            __builtin_amdgcn_fence(__ATOMIC_RELEASE, "agent");
            asm volatile("s_waitcnt vmcnt(0)" ::: "memory");
            const unsigned og = xb_add(&bar[XB_TOP], 1u);
            const unsigned tg = og / nx;
            if (og + 1u == (tg + 1u) * nx) xb_add(&bar[XB_TOPGEN], 1u);
            else XB_SPIN(xb_ld(&bar[XB_TOPGEN]) == tg, bar);
            __builtin_amdgcn_fence(__ATOMIC_ACQUIRE, "agent");
            xb_add(&bar[XB_XGEN(b.x)], 1u);
            asm volatile("s_waitcnt vmcnt(0)" ::: "memory");
        } else {
            XB_SPIN(xb_ld(&bar[XB_XGEN(b.x)]) == gen, bar);
            __builtin_amdgcn_fence(__ATOMIC_ACQUIRE, "agent");
            asm volatile("s_waitcnt vmcnt(0)" ::: "memory");
        }
    }
    __syncthreads();
}
__global__ void __launch_bounds__(512, 2) fwd_megakernel(Args a) {
    extern __shared__ __attribute__((aligned(16))) unsigned char lds_raw[];
    LAS unsigned char* lds = (LAS unsigned char*)lds_raw;
    cg::grid_group grid = cg::this_grid();
    const int G = gridDim.x, NGW = G * 8, GT = G * 512;
    volatile LAS unsigned* bst = (volatile LAS unsigned*)(lds + LDS_BYTES - 16);
    if (threadIdx.x < 2) bst[threadIdx.x] = 0u;
    __syncthreads();
    const XcdBarrier xbar = xcd_barrier_post((unsigned*)(a.ws + WS_BAR), bst);
    for (int ph = a.ph_lo; ph < a.ph_hi; ++ph) {
        bool ran = true;
        int tid = threadIdx.x; asm volatile("" : "+v"(tid));
        int oz = 0; asm volatile("" : "+s"(oz));
        const int lane = tid & 63, wave = __builtin_amdgcn_readfirstlane(tid >> 6), gw = blockIdx.x * 8 + wave, gt = blockIdx.x * 512 + tid;
    unsigned char* ws = a.ws + oz;
    float* X = a.out + oz;
    float* out_vs = X + (size_t)M * D;
    float* out_bconv_p = out_vs + 2 * 32 * 32 * 512;
    float* out_bh_p = out_bconv_p + 2 * 2 * 3 * 512;
    float* out_cc_p = out_bh_p + 2 * 2 * 512;
    float* out_bconv_s = out_cc_p + 2 * 2 * 2 * 1024;
    float* out_bh_s = out_bconv_s + 2 * 32 * 3 * 512;
    float* out_cc_s = out_bh_s + 2 * 32 * 512;
    bf16_t* HN = (bf16_t*)(ws + WS_HN); bf16_t* BXb = (bf16_t*)(ws + WS_BX); bf16_t* RA = (bf16_t*)(ws + WS_RA);

        if (ph == 0) {
 for (int rp = 0; rp < (PROBE == 7 ? 2 : 1); ++rp) { phase_prologue(a, lds, gw, NGW, wave, lane); if (PROBE == 7) __syncthreads(); }
}
        else {
            const int l = (ph - 1) / 10, s = (ph - 1) % 10; const bool even = !(l & 1); const int e = l >> 1;
            if (s == 0 || s == 5 || s == 7 || s == 8) {
                const bf16_t* gA; const bf16_t* gB; int gN, gK, emode, eldc; bf16_t* eO0; bf16_t* eP1 = (bf16_t*)(ws + WS_RA + MT);
                if (s == 0) { gA = HN; gB = (const bf16_t*)(ws + WS_WIN); gN = even ? 2048 : 3072; gK = 1024; eO0 = RA;
                    if (even) { emode = 2; eldc = 512; }
                    else { emode = 3; eldc = 1024; } }
                else if (s == 5) { gA = BXb; gB = (const bf16_t*)(ws + WS_WOUT); gN = 1024; gK = 1024; emode = 0; eO0 = RA; eldc = 1024; }
                else if (s == 7) { gA = HN; gB = (const bf16_t*)(ws + WS_WUP); gN = 4096; gK = 1024; emode = 1; eO0 = RA; eldc = 4096; }
                else { gA = RA; gB = (const bf16_t*)(ws + WS_WDN); gN = 1024; gK = 4096; emode = 0; eO0 = BXb; eldc = 1024; }
                const pg8::Gemm g{gA, gB, M, gN, gK};
                const pg8::EpiMulti E{emode, eO0, eldc, eP1, (float*)(ws + WS_VSS), (bf16_t*)(ws + WS_PART), (const float*)(ws + WS_RSTD)};
                pg8::SplitOrder S; S.init(gN, gK, G, (int)blockIdx.x, s == 5 ? 4 : (s == 8 ? 8 : 1));
                for (int rp = 0; rp < ((PROBE == 6 || (PROBE == 60 && s == 0) || (PROBE == 65 && s == 5) || (PROBE == 67 && s == 7) || (PROBE == 68 && s == 8)) ? 2 : 1); ++rp) pg8::gemm_phase<pg8::EpiMulti, pg8::SplitOrder, true, true>(lds, g, S, E);
                const int bx = (int)blockIdx.x;
                if (s == 7 && l < 3 && bx >= 64) convert_weights(a, l + 1, 3, lds, (bx - 64) * 8 + wave, (G - 64) * 8, wave, lane);
                else if (s == 8 && l < 3 && bx >= 128) convert_weights(a, l + 1, 4, lds, (bx - 128) * 8 + wave, (G - 128) * 8, wave, lane);
                else if (s == 0 && bx >= 48) convert_weights(a, l, l == 0 ? 14 : 8, lds, (bx - 48) * 8 + wave, (G - 48) * 8, wave, lane);
            } else if (s == 1) {
                if (even) {
                    for (int rp = 0; rp < (PROBE == 2 ? 2 : 1); ++rp)
                    for (int it = blockIdx.x; it < 544 + 272; it += G) {
                        if (it < 544) gating_item(a, e, it, out_vs + (size_t)e * 32 * 32 * 512, lds, tid, wave, lane);
                        if (it >= 544) gates_item(a, e, it - 544, lds, wave, lane);
                    }
                } else { for (int rp = 0; rp < (PROBE == 5 ? 2 : 1); ++rp) phase_conv_odd(a, e, out_cc_p, out_cc_s, gt, GT); }
            } else if (s == 2) { ran = false; }
            else if (s == 3) { if (even) phase_scan_carry(a, gw, NGW, lane); else ran = false; }
            else if (s == 4) { if (even) { for (int rp = 0; rp < (PROBE == 4 ? 2 : 1); ++rp) phase_scan_apply(a, e, out_bconv_p, out_bh_p, out_bconv_s, out_bh_s, gt, GT); } else ran = false; }
            else if (s == 6) phase_rows(a.in[6] + l * 1024, RA, (const bf16_t*)(ws + WS_PART), 4, HN, (float*)(ws + WS_RSTD), nullptr, gw, NGW, lane);
            else {
                phase_rows(a.in[8] + l * 1024, BXb, (const bf16_t*)(ws + WS_PART), 8, HN, (float*)(ws + WS_RSTD), l < 3 ? nullptr : X, gw, NGW, lane);
            }
        }
        if (ran && ph + 1 < a.ph_hi) { if (a.ph_hi < 0) grid.sync(); else xcd_barrier(xbar); if (PROBE == 1) xcd_barrier(xbar); }
    }
}

extern "C" void kernel_launch(void* const* d_in, const int* in_sizes, int n_in, void* d_out, int out_size, void* d_ws, size_t ws_size, hipStream_t stream) {
    static int grid = 0;
    if (grid == 0) {
        int dev = 0, cus = 0, per_cu = 0;
        if (hipGetDevice(&dev) != hipSuccess || hipDeviceGetAttribute(&cus, hipDeviceAttributeMultiprocessorCount, dev) != hipSuccess) { fprintf(stderr, "kernel_launch: device query failed\n"); grid = -1; return; }
        if (hipFuncSetAttribute((const void*)fwd_megakernel, hipFuncAttributeMaxDynamicSharedMemorySize, LDS_BYTES) != hipSuccess) { fprintf(stderr, "kernel_launch: hipFuncSetAttribute failed\n"); grid = -1; return; }
        if (hipOccupancyMaxActiveBlocksPerMultiprocessor(&per_cu, (const void*)fwd_megakernel, 512, LDS_BYTES) != hipSuccess || per_cu < 1) { fprintf(stderr, "kernel_launch: occupancy query says %d\n", per_cu); per_cu = 1; }
        (void)hipGetLastError();
        if (n_in != 26 || ws_size < WS_CARRY + 1 * MiB) { fprintf(stderr, "kernel_launch: unexpected n_in %d / ws_size %zu (need %zu)\n", n_in, ws_size, (size_t)(WS_CARRY + 1 * MiB)); grid = -1; return; }
        grid = cus;
    }
    if (grid < 0) return;
    Args a{};
    for (int i = 0; i < 26; ++i) a.in[i] = (const float*)d_in[i];
    a.out = (float*)d_out; a.ws = (unsigned char*)d_ws; a.ph_lo = 0; a.ph_hi = 41;
    if (hipMemsetAsync((char*)d_ws + WS_BAR, 0, XCD_BAR_WORDS * sizeof(unsigned), stream) != hipSuccess) { fprintf(stderr, "kernel_launch: memset of barrier words failed\n"); return; }
    void* args[] = {&a};
    hipError_t e = hipLaunchCooperativeKernel((const void*)fwd_megakernel, dim3(grid), dim3(512), args, LDS_BYTES, stream);
    if (e != hipSuccess) fprintf(stderr, "kernel_launch: cooperative launch failed: %s (grid %d)\n", hipGetErrorString(e), grid);
}
```

```cpp
#include <hip/hip_runtime.h>
#include <hip/hip_cooperative_groups.h>
#include <cstdio>
#include <cstdint>
#ifndef PROBE
#define PROBE 0
#endif
namespace cg = cooperative_groups;
namespace pg8 {
#define PG8_LAS __attribute__((address_space(3)))
typedef unsigned short bf16_t;
typedef short bf16x8 __attribute__((ext_vector_type(8)));
typedef float f32x4 __attribute__((ext_vector_type(4)));
typedef unsigned u32x4 __attribute__((ext_vector_type(4)));
constexpr int BM = 256, BK = 64, HALF = 128, HTB = HALF * BK * 2  , STAGE_BYTES = 8 * HTB, NXCD = 8, WGM = 8;

__host__ __device__ __forceinline__ int lds_byte(int r, int c) { const int st = (r >> 4) * 2 + (c >> 5), rr = r & 15, cc = c & 31, ob = rr * 64 + cc * 2; return st * 1024 + (ob ^ (((ob >> 9) & 1) << 5)); }
__host__ __device__ __forceinline__ void stage_rc(int b, int& R, int& C) { const int st = b / 1024, sb = b % 1024, swz = sb ^ (((sb >> 9) & 1) << 5); R = (st >> 1) * 16 + swz / 64; C = (st & 1) * 32 + (swz % 64) / 2; }
__host__ __device__ __forceinline__ int perm32(int rho) { const int n = rho >> 4, i = rho & 15; return 8 * (i >> 2) + 4 * n + (i & 3); }

struct Unit { int pm, pn, kb, nt, part; };
struct Gemm { const bf16_t* A; const bf16_t* Bt; int M, N, K; };

struct StaticOrder {
    int nM, nN, nwg, G, c;
    __host__ __device__ void init(int M, int N, int G_, int c_) { nM = M / BM; nN = N / BM; nwg = nM * nN; G = G_; c = c_; }
    __host__ __device__ bool next(int i, Unit& u) const {
        const long L = (long)i * G + c; if (L >= nwg) return false;
        int wgid = (int)L; { const int q = nwg / NXCD, r = nwg % NXCD, xcd = wgid % NXCD, off = wgid / NXCD; wgid = (xcd < r ? xcd * (q + 1) : r * (q + 1) + (xcd - r) * q) + off; }
        const int nig = WGM * nN, gid = wgid / nig, fm = gid * WGM, gsz = (nM - fm) < WGM ? (nM - fm) : WGM;
        u.pm = fm + ((wgid % nig) % gsz); u.pn = (wgid % nig) / gsz; return true;
    }
    __device__ __forceinline__ void a_ready(const Unit&) const {}
    __device__ __forceinline__ void done(const Unit&) const {}
};

struct SplitOrder {
    int nN, G, c, n_prompt, n_total, S, nt_full, nt_split;
    __device__ void init(int N, int K, int G_, int c_, int S_) { nN = N / BM; G = G_; c = c_; S = S_; n_prompt = 64 * nN; n_total = n_prompt + 4 * nN * S; nt_full = K / BK; nt_split = nt_full / S; }
    __device__ bool next(int i, Unit& u) const {
        const int L = i * G + c; if (L >= n_total) return false;
        if (L < n_prompt) { int wgid = L; { const int q = n_prompt / NXCD, xcd = wgid % NXCD, off = wgid / NXCD; wgid = xcd * q + off; }
            const int nig = WGM * nN, gid = wgid / nig; u.pm = gid * WGM + ((wgid % nig) % WGM); u.pn = (wgid % nig) / WGM; u.kb = 0; u.nt = nt_full; u.part = -1; }
        else { const int q = L - n_prompt, p = q % S, r = q / S; u.pm = 64 + (r & 3); u.pn = r >> 2; u.kb = p * nt_split * BK * 2; u.nt = nt_split; u.part = (S > 1) ? p : -1; }
        return true;
    }
    __device__ __forceinline__ void a_ready(const Unit&) const {}
    __device__ __forceinline__ void done(const Unit&) const {}
};
typedef float f32x2 __attribute__((ext_vector_type(2)));
__device__ __forceinline__ unsigned cvt_pk_bf16(float lo, float hi) { unsigned r; asm("v_cvt_pk_bf16_f32 %0, %1, %2" : "=v"(r) : "v"(lo), "v"(hi)); return r; }
template <class Epi, class Sched, bool ALIGN_EPI = false, bool SP2 = false>
__device__ __forceinline__ void gemm_phase(PG8_LAS unsigned char* lds, const Gemm g, const Sched& S, const Epi& E) {
    int tid = threadIdx.x; asm volatile("" : "+v"(tid));
    const int wid = __builtin_amdgcn_readfirstlane(tid >> 6), lane = tid & 63, wr = wid >> 2, wc = wid & 3, fr = lane & 15, fq = lane >> 4;
    const int K = g.K;
    unsigned voffA[2], voffB[2];
#pragma unroll
    for (int i = 0; i < 2; ++i) { int R, C; stage_rc(tid * 16 + i * 8192, R, C); const int Rb = Epi::PERM ? ((R & ~31) + perm32(R & 31)) : R;
        voffA[i] = (unsigned)(R * K + C) * 2u; voffB[i] = (unsigned)(Rb * K + C) * 2u; }
    const size_t kstep = (size_t)(BK * 2);
    const size_t hstep = (size_t)HALF * K * 2;
    const size_t tstep = 2 * hstep;
    const unsigned ldsw = (unsigned)wid * 1024u;
    const int aoff = lds_byte(wr * 64 + fr, fq * 8), boff = lds_byte(wc * 32 + fr, fq * 8);
#define PG8_SA(b, h) (((b) * 2 + (h)) * HTB)
#define PG8_SB(b, h) ((4 + (b) * 2 + (h)) * HTB)
#define PG8_STAGE(bufoff, gbase, voff) do { _Pragma("unroll") for (int _i = 0; _i < 2; ++_i) \
        __builtin_amdgcn_global_load_lds((const unsigned*)((const char*)(gbase) + (voff)[_i]), (PG8_LAS unsigned*)(lds + (bufoff) + ldsw + _i * 8192), 16, 0, 0); } while (0)
#define PG8_LDA(dst, b, h) do { _Pragma("unroll") for (int m = 0; m < 4; ++m) _Pragma("unroll") for (int k = 0; k < 2; ++k) dst[m][k] = *(const PG8_LAS bf16x8*)(lds + PG8_SA(b, h) + aoff + m * 2048 + k * 1024); } while (0)
#define PG8_LDB(dst, b, h) do { _Pragma("unroll") for (int n = 0; n < 2; ++n) _Pragma("unroll") for (int k = 0; k < 2; ++k) dst[n][k] = *(const PG8_LAS bf16x8*)(lds + PG8_SB(b, h) + boff + n * 2048 + k * 1024); } while (0)
#define PG8_MMA(ai, bj, At, Bt) do { __builtin_amdgcn_s_setprio(1); _Pragma("unroll") for (int m = 0; m < 4; ++m) _Pragma("unroll") for (int n = 0; n < 2; ++n) _Pragma("unroll") for (int k = 0; k < 2; ++k) \
        acc[ai][bj][m][n] = __builtin_amdgcn_mfma_f32_16x16x32_bf16(Bt[n][k], At[m][k], acc[ai][bj][m][n], 0, 0, 0); __builtin_amdgcn_s_setprio(0); } while (0)
#define PG8_WAIT_V(n) asm volatile("s_waitcnt vmcnt(" #n ")" ::: "memory")
#define PG8_WAIT_L(n) asm volatile("s_waitcnt lgkmcnt(" #n ")" ::: "memory")
#define PG8_BAR __builtin_amdgcn_s_barrier()
#define PG8_SCHED __builtin_amdgcn_sched_barrier(0)
    Unit cur, nxt; int ui = 0;
    if (!S.next(0, cur)) return;
    f32x4 acc[2][2][4][2];
#pragma unroll
    for (int a = 0; a < 2; ++a)
#pragma unroll
        for (int b = 0; b < 2; ++b)
#pragma unroll
            for (int m = 0; m < 4; ++m)
#pragma unroll
                for (int n = 0; n < 2; ++n) acc[a][b][m][n] = (f32x4){0.f, 0.f, 0.f, 0.f};
    bf16x8 At[4][2], B0[2][2], B1[2][2];
    const char* cA = (const char*)g.A + (size_t)cur.pm * tstep + cur.kb; const char* cB = (const char*)g.Bt + (size_t)cur.pn * tstep + cur.kb;
    S.a_ready(cur);
    if constexpr (SP2) {
        PG8_STAGE(PG8_SB(0, 0), cB, voffB); PG8_STAGE(PG8_SB(0, 1), cB + hstep, voffB); PG8_STAGE(PG8_SA(0, 0), cA, voffA); PG8_STAGE(PG8_SA(0, 1), cA + hstep, voffA);
        if (wr == 1) PG8_BAR;
        PG8_WAIT_V(2); PG8_BAR;
        PG8_STAGE(PG8_SB(1, 0), cB + kstep, voffB); PG8_STAGE(PG8_SA(1, 0), cA + kstep, voffA); PG8_STAGE(PG8_SB(1, 1), cB + hstep + kstep, voffB);
        PG8_WAIT_V(6); PG8_BAR;
    } else {
        PG8_STAGE(PG8_SB(0, 0), cB, voffB); PG8_STAGE(PG8_SA(0, 0), cA, voffA); PG8_STAGE(PG8_SB(0, 1), cB + hstep, voffB); PG8_STAGE(PG8_SA(0, 1), cA + hstep, voffA);
        if (wr == 1) PG8_BAR;
        PG8_WAIT_V(4); PG8_BAR;
        PG8_STAGE(PG8_SB(1, 0), cB + kstep, voffB); PG8_STAGE(PG8_SA(1, 0), cA + kstep, voffA); PG8_STAGE(PG8_SB(1, 1), cB + hstep + kstep, voffB);
        PG8_WAIT_V(6); PG8_BAR;
    }
    for (;;) {
        const bool has_next = S.next(ui + 1, nxt);
        const char* nA = has_next ? (const char*)g.A + (size_t)nxt.pm * tstep + nxt.kb : cA; const char* nB = has_next ? (const char*)g.Bt + (size_t)nxt.pn * tstep + nxt.kb : cB;
        const int nt = cur.nt;
        for (int t = 0; t < nt; t += 2) {
            const bool last = (t == nt - 2);
            const char* a1 = cA + (size_t)(t + 1) * kstep;
            const char* a2 = last ? nA : cA + (size_t)(t + 2) * kstep; const char* b2 = last ? nB : cB + (size_t)(t + 2) * kstep;
            const char* a3 = a2 + kstep; const char* b3 = b2 + kstep;
            if (last && has_next) S.a_ready(nxt);
            if constexpr (SP2) {
            PG8_LDB(B0, 0, 0); PG8_LDB(B1, 0, 1); PG8_SCHED; PG8_LDA(At, 0, 0); PG8_STAGE(PG8_SA(1, 1), a1 + hstep, voffA);
            PG8_WAIT_V(8); PG8_WAIT_L(0); PG8_BAR; PG8_MMA(0, 0, At, B0); PG8_MMA(0, 1, At, B1); PG8_BAR; PG8_SCHED;
            PG8_LDA(At, 0, 1); PG8_STAGE(PG8_SB(0, 0), b2, voffB); PG8_STAGE(PG8_SB(0, 1), b2 + hstep, voffB); PG8_STAGE(PG8_SA(0, 0), a2, voffA);
            PG8_WAIT_V(8); PG8_WAIT_L(0); PG8_BAR; PG8_MMA(1, 0, At, B0); PG8_MMA(1, 1, At, B1); PG8_BAR; PG8_SCHED;
            PG8_LDB(B0, 1, 0); PG8_LDB(B1, 1, 1); PG8_SCHED; PG8_LDA(At, 1, 0); PG8_STAGE(PG8_SA(0, 1), a2 + hstep, voffA);
            PG8_WAIT_V(8); PG8_WAIT_L(0); PG8_BAR; PG8_MMA(0, 0, At, B0); PG8_MMA(0, 1, At, B1); PG8_BAR; PG8_SCHED;
            PG8_LDA(At, 1, 1); PG8_STAGE(PG8_SB(1, 0), b3, voffB); PG8_STAGE(PG8_SB(1, 1), b3 + hstep, voffB); PG8_STAGE(PG8_SA(1, 0), a3, voffA);
            PG8_WAIT_V(8); PG8_WAIT_L(0); PG8_BAR; PG8_MMA(1, 0, At, B0); PG8_MMA(1, 1, At, B1); PG8_BAR; PG8_SCHED;
            } else {
            PG8_LDB(B0, 0, 0); PG8_SCHED; PG8_LDA(At, 0, 0); PG8_STAGE(PG8_SA(1, 1), a1 + hstep, voffA);
            PG8_WAIT_L(8); PG8_BAR; PG8_WAIT_L(0); PG8_MMA(0, 0, At, B0); PG8_BAR; PG8_SCHED;
            PG8_LDB(B1, 0, 1); PG8_STAGE(PG8_SB(0, 0), b2, voffB);
            PG8_BAR; PG8_WAIT_L(0); PG8_MMA(0, 1, At, B1); PG8_BAR;
            PG8_LDA(At, 0, 1); PG8_STAGE(PG8_SA(0, 0), a2, voffA);
            PG8_BAR; PG8_WAIT_L(0); PG8_MMA(1, 0, At, B0); PG8_BAR; PG8_SCHED;
            PG8_STAGE(PG8_SB(0, 1), b2 + hstep, voffB);
            PG8_WAIT_V(6); PG8_BAR; PG8_MMA(1, 1, At, B1); PG8_BAR;
            PG8_LDB(B0, 1, 0); PG8_SCHED; PG8_LDA(At, 1, 0); PG8_STAGE(PG8_SA(0, 1), a2 + hstep, voffA);
            PG8_WAIT_L(8); PG8_BAR; PG8_WAIT_L(0); PG8_MMA(0, 0, At, B0); PG8_BAR; PG8_SCHED;
            PG8_LDB(B1, 1, 1); PG8_STAGE(PG8_SB(1, 0), b3, voffB);
            PG8_BAR; PG8_WAIT_L(0); PG8_MMA(0, 1, At, B1); PG8_BAR;
            PG8_LDA(At, 1, 1); PG8_STAGE(PG8_SA(1, 0), a3, voffA);
            PG8_BAR; PG8_WAIT_L(0); PG8_MMA(1, 0, At, B0); PG8_BAR; PG8_SCHED;
            PG8_STAGE(PG8_SB(1, 1), b3 + hstep, voffB);
            PG8_WAIT_V(6); PG8_BAR; PG8_MMA(1, 1, At, B1); PG8_BAR;
            }
        }
        if constexpr (ALIGN_EPI) { if (wr == 0) PG8_BAR; }
        if constexpr (!Epi::AFTER_DRAIN) { E(acc, cur, wr, wc, fr, fq); S.done(cur); }
        if (!has_next) break;
#pragma unroll
        for (int a = 0; a < 2; ++a)
#pragma unroll
            for (int b = 0; b < 2; ++b)
#pragma unroll
                for (int m = 0; m < 4; ++m)
#pragma unroll
                    for (int n = 0; n < 2; ++n) acc[a][b][m][n] = (f32x4){0.f, 0.f, 0.f, 0.f};
        cur = nxt; cA = nA; cB = nB; ++ui;
        if constexpr (ALIGN_EPI) { if (wr == 1) PG8_BAR; }
    }
    PG8_WAIT_V(0);
    if constexpr (!ALIGN_EPI) { if (wr == 0) PG8_BAR; }
    PG8_BAR;
    if constexpr (Epi::AFTER_DRAIN) { E.fused(acc, cur, wr, wc, fr, fq, lds, wid, lane); S.done(cur); }
#undef PG8_SA
#undef PG8_SB
#undef PG8_STAGE
#undef PG8_LDA
#undef PG8_LDB
#undef PG8_MMA
#undef PG8_WAIT_V
#undef PG8_WAIT_L
#undef PG8_BAR
#undef PG8_SCHED
}
}
namespace pg8 {
typedef unsigned u32x2 __attribute__((ext_vector_type(2)));
__device__ __forceinline__ float gelu_f(float x) {
    const float t = x * (1.5957691216057308f + 0.0713548162726f * x * x);
    return x * __builtin_amdgcn_rcpf(1.0f + __builtin_amdgcn_exp2f(-1.4426950408889634f * t));
}
__device__ __forceinline__ f32x4 gelu4(const f32x4 x) {
    const f32x4 t = x * (x * x * (-1.4426950408889634f * 0.0713548162726f) + (-1.4426950408889634f * 1.5957691216057308f));
    f32x4 r; r.x = __builtin_amdgcn_rcpf(1.0f + __builtin_amdgcn_exp2f(t.x)); r.y = __builtin_amdgcn_rcpf(1.0f + __builtin_amdgcn_exp2f(t.y));
    r.z = __builtin_amdgcn_rcpf(1.0f + __builtin_amdgcn_exp2f(t.z)); r.w = __builtin_amdgcn_rcpf(1.0f + __builtin_amdgcn_exp2f(t.w));
    return x * r;
}
__device__ __forceinline__ u32x4 pack8(const f32x4& v0, const f32x4& v1) { return (u32x4){cvt_pk_bf16(v0[0], v0[1]), cvt_pk_bf16(v0[2], v0[3]), cvt_pk_bf16(v1[0], v1[1]), cvt_pk_bf16(v1[2], v1[3])}; }
__device__ __forceinline__ u32x4 xpose16(const u32x4 o, int srclane) { return (u32x4){(unsigned)__shfl((int)o.x, srclane), (unsigned)__shfl((int)o.y, srclane), (unsigned)__shfl((int)o.z, srclane), (unsigned)__shfl((int)o.w, srclane)}; }
struct EpiMulti {
    static constexpr bool PERM = true, AFTER_DRAIN = false;
    int mode;
    bf16_t* O0; int ldc;
    bf16_t* P1; float* VSS; bf16_t* PART; const float* RS;
    __device__ __forceinline__ void operator()(const f32x4 (&acc)[2][2][4][2], const Unit& u, int wr, int wc, int fr, int fq) const {
        const int row0 = u.pm * BM + wr * 64 + fr;
        const int lane_ = fq * 16 + fr, sl = (lane_ & 3) * 16 + (lane_ >> 2), r2 = lane_ >> 2, p2 = lane_ & 3, rowT = u.pm * BM + wr * 64 + r2;
        float rsv[2][4];
#pragma unroll
        for (int ai = 0; ai < 2; ++ai)
#pragma unroll
            for (int m = 0; m < 4; ++m) rsv[ai][m] = (mode != 0) ? RS[row0 + ai * HALF + m * 16] : 1.0f;
        if (mode == 0 || mode == 1 || (mode == 3 && u.pn < 4)) {
            const int col0 = u.pn * BM + wc * 32 + 8 * p2;
            bf16_t* const obase = (u.part >= 0) ? PART + ((size_t)u.part * 1024 - 16384) * 1024 : O0;
#pragma unroll
            for (int ai = 0; ai < 2; ++ai)
#pragma unroll
                for (int m = 0; m < 4; ++m) { bf16_t* rowp = obase + (size_t)(rowT + ai * HALF + m * 16) * ldc + col0;
                    const float rs = rsv[ai][m];
#pragma unroll
                    for (int bj = 0; bj < 2; ++bj) { f32x4 v0 = acc[ai][bj][m][0], v1 = acc[ai][bj][m][1];
                        if (mode == 1) { const f32x4 z = {0.f, 0.f, 0.f, 0.f}; v0 = __builtin_elementwise_max(v0 * rs, z); v1 = __builtin_elementwise_max(v1 * rs, z); v0 = v0 * v0; v1 = v1 * v1; }
                        else if (mode == 3) { v0 = v0 * rs; v1 = v1 * rs; }
                        *(u32x4*)(rowp + bj * HALF) = xpose16(pack8(v0, v1), sl); } }
        } else if (mode == 2) {
            const int kind = u.pn >> 1; bf16_t* dst = O0 + (size_t)kind * ((size_t)17408 * 512);
            const int col0 = (u.pn & 1) * 256 + wc * 32 + 8 * p2;
#pragma unroll
            for (int ai = 0; ai < 2; ++ai)
#pragma unroll
                for (int m = 0; m < 4; ++m) { const int row = row0 + ai * HALF + m * 16; bf16_t* rowp = dst + (size_t)(rowT + ai * HALF + m * 16) * 512 + col0; float ss = 0.f; const float rs = rsv[ai][m];
#pragma unroll
                    for (int bj = 0; bj < 2; ++bj) { f32x4 v0 = acc[ai][bj][m][0] * rs, v1 = acc[ai][bj][m][1] * rs;
                        if (kind == 1 || kind == 3) { v0 = gelu4(v0); v1 = gelu4(v1); const f32x4 q = v0 * v0 + v1 * v1; ss += (q.x + q.y) + (q.z + q.w); }
                        *(u32x4*)(rowp + bj * HALF) = xpose16(pack8(v0, v1), sl); }
                    if (kind == 1) { ss += __shfl_xor(ss, 16); ss += __shfl_xor(ss, 32); if (fq == 0) VSS[(size_t)row * 8 + (u.pn & 1) * 4 + wc] = ss; } }
        } else {
            const int col0 = (u.pn - 4) * 128 + wc * 32 + 8 * p2;
#pragma unroll
            for (int ai = 0; ai < 2; ++ai)
#pragma unroll
                for (int m = 0; m < 4; ++m) { bf16_t* rowp = P1 + (size_t)(rowT + ai * HALF + m * 16) * 1024 + col0; float rs = rsv[ai][m]; rs *= rs;
                    const f32x4 v0 = acc[ai][0][m][0] * acc[ai][1][m][0] * rs, v1 = acc[ai][0][m][1] * acc[ai][1][m][1] * rs;
                    *(u32x4*)rowp = xpose16(pack8(v0, v1), sl); }
        }
    }
};
}

#define LAS __attribute__((address_space(3)))
typedef unsigned short bf16_t;
typedef short bf16x8 __attribute__((ext_vector_type(8)));
typedef float f32x4 __attribute__((ext_vector_type(4)));
typedef unsigned u32x4 __attribute__((ext_vector_type(4)));
typedef unsigned u32x2 __attribute__((ext_vector_type(2)));
#define LDS_WAIT() asm volatile("s_waitcnt lgkmcnt(0)" ::: "memory")
using pg8::cvt_pk_bf16; using pg8::pack8; using pg8::gelu_f; using pg8::gelu4;

constexpr int M = 17408, MP = 16384, MS = 1024, D = 1024, FF = 4096;
constexpr float EPS = 1e-6f;
constexpr size_t MiB = 1u << 20;
constexpr size_t MT = (size_t)M * 1024 * 2;
constexpr size_t WS_WIN = 0, WS_WOUT = 6 * MiB, WS_WUP = 8 * MiB, WS_WDN = 16 * MiB;
constexpr size_t WS_SMALL = 24 * MiB;
constexpr size_t WS_WG = WS_SMALL, WS_GWA = WS_SMALL + 512 * 1024, WS_GWX = WS_SMALL + 640 * 1024, WS_SP = WS_SMALL + 768 * 1024;
constexpr size_t WS_BAS = WS_SP + 4096, WS_BXS = WS_SP + 8192;
constexpr size_t WS_AGGA = WS_SMALL + 1 * MiB, WS_AGGB = WS_SMALL + 2 * MiB + 128 * 1024, WS_VSS = WS_SMALL + 3 * MiB + 256 * 1024;
constexpr size_t WS_BAR = WS_SMALL + 3 * MiB + 832 * 1024;
constexpr size_t WS_RSTD = WS_SMALL + 3 * MiB + 896 * 1024;
constexpr size_t WS_HN = 28 * MiB, WS_BX = WS_HN + MT, WS_RA = WS_BX + MT, WS_END = WS_RA + 4 * MT;
constexpr size_t WS_PART = WS_END;
constexpr size_t WS_CARRY = WS_PART + 16 * MiB;
static_assert(WS_CARRY + 1 * MiB <= 256 * MiB, "workspace map");
constexpr int NCH32 = M / 32;
constexpr int LDS_BYTES = 147456;

struct Args { const float* in[26]; float* out; unsigned char* ws; int ph_lo, ph_hi; };

__device__ __forceinline__ float bflo(unsigned p) { return __builtin_bit_cast(float, p << 16); }
__device__ __forceinline__ float bfhi(unsigned p) { return __builtin_bit_cast(float, p & 0xffff0000u); }
__device__ __forceinline__ float bf2f(bf16_t b) { return __builtin_bit_cast(float, (unsigned)b << 16); }
__device__ __forceinline__ bf16_t f2bf(float f) { unsigned u = __builtin_bit_cast(unsigned, f); return (bf16_t)((u + 0x7fffu + ((u >> 16) & 1u)) >> 16); }
__device__ __forceinline__ float wave_sum(float v) {
#pragma unroll
    for (int o = 1; o < 64; o <<= 1) v += __shfl_xor(v, o);
    return v;
}
__device__ __forceinline__ float sigmoid_f(float x) { return __builtin_amdgcn_rcpf(1.0f + __builtin_amdgcn_exp2f(-1.4426950408889634f * x)); }
__device__ __forceinline__ float exp_f(float x) { return __builtin_amdgcn_exp2f(1.4426950408889634f * x); }

__device__ __forceinline__ const float* sel_ptr(bool c, const float* p, const float* q) { asm volatile("" : "+s"(p), "+s"(q)); return c ? p : q; }
__device__ __forceinline__ void transpose_item(const float* W, int N, int K, const float* gain, bf16_t* WT, int dst_n0, int src_n0, int k0, LAS float* scr, int lane) {
#pragma unroll 8
    for (int i = 0; i < 32; ++i) { const int kk = 2 * i + (lane >> 5); float v = __builtin_nontemporal_load(W + (size_t)(k0 + kk) * N + src_n0 + (lane & 31)); if (gain) v *= gain[k0 + kk]; scr[kk * 33 + (lane & 31)] = v; }
    LDS_WAIT();
    const int c = lane & 7;
#pragma unroll
    for (int j = 0; j < 4; ++j) { const int n = (lane >> 3) + 8 * j; const LAS float* s = scr + (8 * c) * 33 + n;
        u32x4 o; o.x = cvt_pk_bf16(s[0 * 33], s[1 * 33]); o.y = cvt_pk_bf16(s[2 * 33], s[3 * 33]); o.z = cvt_pk_bf16(s[4 * 33], s[5 * 33]); o.w = cvt_pk_bf16(s[6 * 33], s[7 * 33]);
        *(u32x4*)(WT + (size_t)(dst_n0 + n) * K + k0 + 8 * c) = o; }
    LDS_WAIT();
}
__device__ __forceinline__ void convert_weights(const Args& a, int l, int mask, LAS unsigned char* lds, int gw, int NGW, int wave, int lane) {
    LAS float* scr = (LAS float*)(lds + wave * 16384);
    const bool even = !(l & 1); const int e = l >> 1;
    const int Nin = even ? 2048 : 3072;
    const float* Win = sel_ptr(even, a.in[9], a.in[21]) + (size_t)e * 1024 * Nin;
    const float* Wout = sel_ptr(even, a.in[20], a.in[23]) + (size_t)e * 1024 * 1024;
    const float* Wup = a.in[24] + (size_t)l * 1024 * 4096; const float* Wdn = a.in[25] + (size_t)l * 4096 * 1024;
    const float* g_in = a.in[5] + l * 1024; const float* g_up = a.in[7] + l * 1024;
    bf16_t* WinT = (bf16_t*)(a.ws + WS_WIN); bf16_t* WoutT = (bf16_t*)(a.ws + WS_WOUT); bf16_t* WupT = (bf16_t*)(a.ws + WS_WUP); bf16_t* WdnT = (bf16_t*)(a.ws + WS_WDN);
    const int I_in = (mask & 1) ? 16 * (Nin / 32) : 0, I_out = (mask & 2) ? 16 * 32 : 0, I_up = (mask & 4) ? 16 * 128 : 0, I_dn = (mask & 8) ? 64 * 32 : 0, total = I_in + I_out + I_up + I_dn;
    for (int it = gw; it < total; it += NGW) {
        int r = it;
        if (r < I_in) { const int nblk = Nin / 32, kb = r / nblk, nb = r % nblk, d0 = 32 * nb; int s0 = d0;
            if (!even && d0 >= 1024) { const int q = d0 - 1024, p = q >> 8, b = (q >> 7) & 1, i = q & 127; s0 = 1024 + b * 1024 + 128 * p + i; }
            transpose_item(Win, Nin, 1024, g_in, WinT, d0, s0, 64 * kb, scr, lane); continue; }
        r -= I_in;
        if (r < I_out) { const int kb = r / 32, nb = r % 32; transpose_item(Wout, 1024, 1024, nullptr, WoutT, 32 * nb, 32 * nb, 64 * kb, scr, lane); continue; }
        r -= I_out;
        if (r < I_up) { const int kb = r / 128, nb = r % 128; transpose_item(Wup, 4096, 1024, g_up, WupT, 32 * nb, 32 * nb, 64 * kb, scr, lane); continue; }
        r -= I_up;
        { const int kb = r / 32, nb = r % 32; transpose_item(Wdn, 1024, 4096, nullptr, WdnT, 32 * nb, 32 * nb, 64 * kb, scr, lane); }
    }
}

__device__ __forceinline__ void phase_prologue(const Args& a, LAS unsigned char* lds, int gw, int NGW, int wave, int lane) {
    convert_weights(a, 0, 1, lds, gw, NGW, wave, lane);
    const int gt = gw * 64 + lane, GT = NGW * 64;
    bf16_t* WG = (bf16_t*)(a.ws + WS_WG); bf16_t* GWA = (bf16_t*)(a.ws + WS_GWA); bf16_t* GWX = (bf16_t*)(a.ws + WS_GWX); float* SP = (float*)(a.ws + WS_SP);
    for (int i = gt; i < 2 * 2 * 4 * 128 * 128; i += GT) {
        const int j = i & 127, ii = (i >> 7) & 127, h = (i >> 14) & 3, kind = (i >> 16) & 1, e = i >> 17;
        const float* w = a.in[11] + (size_t)(e * 4 + h) * 128 * 128; float v;
        if (kind == 0) v = ((j >> 6) <= (ii >> 6)) ? w[ii * 128 + j] : 0.f;
        else v = ((j >> 5) == (ii >> 5)) ? w[(ii & 31) * 128 + (j & 31)] : 0.f;
        WG[i] = f2bf(v);
    }
    for (int i = gt; i < 2 * 8 * 64 * 64; i += GT) {
        const int ii = i & 63, j = (i >> 6) & 63, eh = i >> 12;
        GWA[i] = f2bf(-1.4426950408889634f * a.in[15][(size_t)(eh * 64 + ii) * 64 + j]); GWX[i] = f2bf(-1.4426950408889634f * a.in[17][(size_t)(eh * 64 + ii) * 64 + j]);
    }
    for (int i = gt; i < 1024; i += GT) { const float nl = -a.in[19][i]; SP[i] = -8.0f * (fmaxf(nl, 0.f) + log1pf(expf(-fabsf(nl))));
        ((float*)(a.ws + WS_BAS))[i] = -1.4426950408889634f * a.in[16][i]; ((float*)(a.ws + WS_BXS))[i] = -1.4426950408889634f * a.in[18][i]; }
    bf16_t* X16 = (bf16_t*)(a.ws + WS_HN); float* RSTD = (float*)(a.ws + WS_RSTD);
    for (int m = gw; m < M; m += NGW) {
        const float* src = ((m < MP) ? a.in[0] + (size_t)m * D : a.in[1] + (size_t)(m - MP) * D) + 8 * lane;
        f32x4 v[4]; v[0] = __builtin_nontemporal_load((const f32x4*)src); v[1] = __builtin_nontemporal_load((const f32x4*)(src + 4)); v[2] = __builtin_nontemporal_load((const f32x4*)(src + 512)); v[3] = __builtin_nontemporal_load((const f32x4*)(src + 516));
        float ss = 0.f;
#pragma unroll
        for (int j = 0; j < 4; ++j) ss += (v[j].x * v[j].x + v[j].y * v[j].y) + (v[j].z * v[j].z + v[j].w * v[j].w);
        const float rstd = 1.0f / sqrtf(wave_sum(ss) * (1.f / D) + EPS);
        u32x4* ho = (u32x4*)(X16 + (size_t)m * D) + lane;
        ho[0] = pack8(v[0], v[1]); ho[64] = pack8(v[2], v[3]);
        if (lane == 0) RSTD[m] = rstd;
    }
}

__device__ __forceinline__ void up8(const u32x4 p, f32x4& a, f32x4& b) { a = (f32x4){bflo(p.x), bfhi(p.x), bflo(p.y), bfhi(p.y)}; b = (f32x4){bflo(p.z), bfhi(p.z), bflo(p.w), bfhi(p.w)}; }
__device__ __forceinline__ void phase_rows(const float* g, const bf16_t* MOb, const bf16_t* PART, int nsplit, bf16_t* X16, float* RSTD, float* Y, int gw, int NGW, int lane) {
    f32x4 gv[4];
    gv[0] = *(const f32x4*)(g + 8 * lane); gv[1] = *(const f32x4*)(g + 8 * lane + 4); gv[2] = *(const f32x4*)(g + 512 + 8 * lane); gv[3] = *(const f32x4*)(g + 512 + 8 * lane + 4);
    for (int m = gw; m < M; m += NGW) {
        u32x4* xr = (u32x4*)(X16 + (size_t)m * D) + lane;
        const u32x4 q0 = __builtin_nontemporal_load(xr), q1 = __builtin_nontemporal_load(xr + 64);
        f32x4 x[4], mo[4];
        if (m < MP) { const u32x4* mr = (const u32x4*)(MOb + (size_t)m * D) + lane; const u32x4 p0 = __builtin_nontemporal_load(mr), p1 = __builtin_nontemporal_load(mr + 64); up8(p0, mo[0], mo[1]); up8(p1, mo[2], mo[3]); }
        else {
#pragma unroll
            for (int j = 0; j < 4; ++j) mo[j] = (f32x4){0.f, 0.f, 0.f, 0.f};
            for (int sp = 0; sp < nsplit; ++sp) { const u32x4* mr = (const u32x4*)(PART + ((size_t)sp * 1024 + (m - MP)) * D) + lane; const u32x4 p0 = __builtin_nontemporal_load(mr), p1 = __builtin_nontemporal_load(mr + 64);
                f32x4 t0, t1, t2, t3; up8(p0, t0, t1); up8(p1, t2, t3); mo[0] += t0; mo[1] += t1; mo[2] += t2; mo[3] += t3; } }
        up8(q0, x[0], x[1]); up8(q1, x[2], x[3]);
        float ss = 0.f;
#pragma unroll
        for (int j = 0; j < 4; ++j) ss += (mo[j].x * mo[j].x + mo[j].y * mo[j].y) + (mo[j].z * mo[j].z + mo[j].w * mo[j].w);
        const float r1 = 1.0f / sqrtf(wave_sum(ss) * (1.f / D) + EPS); float s2 = 0.f;
#pragma unroll
        for (int j = 0; j < 4; ++j) { x[j] = x[j] + mo[j] * gv[j] * r1; s2 += (x[j].x * x[j].x + x[j].y * x[j].y) + (x[j].z * x[j].z + x[j].w * x[j].w); }
        if (Y) { float* yo = Y + (size_t)m * D + 8 * lane;
            *(f32x4*)yo = x[0]; *(f32x4*)(yo + 4) = x[1]; *(f32x4*)(yo + 512) = x[2]; *(f32x4*)(yo + 516) = x[3]; }
        else { const float r2 = 1.0f / sqrtf(wave_sum(s2) * (1.f / D) + EPS);
            xr[0] = pack8(x[0], x[1]); xr[64] = pack8(x[2], x[3]);
            if (lane == 0) RSTD[m] = r2; }
    }
}

__device__ __forceinline__ void unpack8(const u32x4 p, float (&v)[8]) { v[0] = bflo(p.x); v[1] = bfhi(p.x); v[2] = bflo(p.y); v[3] = bfhi(p.y); v[4] = bflo(p.z); v[5] = bfhi(p.z); v[6] = bflo(p.w); v[7] = bfhi(p.w); }
constexpr int VT_STRIDE = 136;
__device__ __forceinline__ void gating_item(const Args& a, int e, int item, float* vs_out, LAS unsigned char* lds, int tid, int wave, int lane) {
    const int tile = item >> 2, h = item & 3, row0 = tile * 128, kind = (tile >= 128) ? 1 : 0, fr = lane & 15, fq = lane >> 4;
    const bf16_t* U = (const bf16_t*)(a.ws + WS_RA); const bf16_t* GV = (const bf16_t*)(a.ws + WS_RA + MT / 2); const float* VSS = (const float*)(a.ws + WS_VSS);
    bf16_t* CAT = (bf16_t*)(a.ws + WS_BX);
    const float* gain = a.in[10] + e * 512 + h * 128;
    LAS bf16_t* Vt = (LAS bf16_t*)lds;
    u32x2 upre[8];
    { const int i = 16 * wave + fr, row = row0 + i;
#pragma unroll
      for (int c = 0; c < 8; ++c) upre[c] = __builtin_nontemporal_load((const u32x2*)(U + (size_t)row * 512 + h * 128 + 16 * c + 4 * fq)); }
    {
        const int j0 = 2 * lane, cw0 = 16 * wave; const size_t ra = (size_t)(row0 + j0), rb = ra + 1;
        const bf16_t* GV = (const bf16_t*)(a.ws + WS_RA + MT / 2); const float* VSS = (const float*)(a.ws + WS_VSS);
        const u32x4 ga0 = __builtin_nontemporal_load((const u32x4*)(GV + ra * 512 + h * 128 + cw0)), ga1 = __builtin_nontemporal_load((const u32x4*)(GV + ra * 512 + h * 128 + cw0 + 8));
        const u32x4 gb0 = __builtin_nontemporal_load((const u32x4*)(GV + rb * 512 + h * 128 + cw0)), gb1 = __builtin_nontemporal_load((const u32x4*)(GV + rb * 512 + h * 128 + cw0 + 8));
        const f32x4 pa0 = *(const f32x4*)(VSS + ra * 8), pa1 = *(const f32x4*)(VSS + ra * 8 + 4), pb0 = *(const f32x4*)(VSS + rb * 8), pb1 = *(const f32x4*)(VSS + rb * 8 + 4);
        const float rsa = 1.0f / sqrtf(((pa0.x + pa0.y) + (pa0.z + pa0.w) + (pa1.x + pa1.y) + (pa1.z + pa1.w)) * (1.f / 512.f) + EPS);
        const float rsb = 1.0f / sqrtf(((pb0.x + pb0.y) + (pb0.z + pb0.w) + (pb1.x + pb1.y) + (pb1.z + pb1.w)) * (1.f / 512.f) + EPS);
        float va[16], vb[16];
        { float t[8]; unpack8(ga0, t);
#pragma unroll
          for (int r = 0; r < 8; ++r) va[r] = t[r] * rsa;
          unpack8(ga1, t);
#pragma unroll
          for (int r = 0; r < 8; ++r) va[8 + r] = t[r] * rsa;
          unpack8(gb0, t);
#pragma unroll
          for (int r = 0; r < 8; ++r) vb[r] = t[r] * rsb;
          unpack8(gb1, t);
#pragma unroll
          for (int r = 0; r < 8; ++r) vb[8 + r] = t[r] * rsb; }
#pragma unroll
        for (int k = 0; k < 16; ++k) *(LAS unsigned*)(Vt + (cw0 + k) * VT_STRIDE + j0) = cvt_pk_bf16(va[k], vb[k]);
        if (kind) { float* oa = vs_out + (ra - MP) * 512 + h * 128 + cw0; float* ob = vs_out + (rb - MP) * 512 + h * 128 + cw0;
#pragma unroll
            for (int q = 0; q < 4; ++q) { const f32x4 g4 = *(const f32x4*)(gain + cw0 + 4 * q);
                *(f32x4*)(oa + 4 * q) = (f32x4){va[4 * q] * g4.x, va[4 * q + 1] * g4.y, va[4 * q + 2] * g4.z, va[4 * q + 3] * g4.w};
                *(f32x4*)(ob + 4 * q) = (f32x4){vb[4 * q] * g4.x, vb[4 * q + 1] * g4.y, vb[4 * q + 2] * g4.z, vb[4 * q + 3] * g4.w}; } }
    }
    __syncthreads();
    const bf16_t* WGp = (const bf16_t*)(a.ws + WS_WG) + (size_t)((e * 2 + kind) * 4 + h) * 128 * 128;
    const int ks_lo = kind ? (wave >> 1) : 0, ks_hi = kind ? (wave >> 1) + 1 : (wave < 4 ? 2 : 4);
    f32x4 acc[8];
#pragma unroll
    for (int c = 0; c < 8; ++c) acc[c] = (f32x4){0.f, 0.f, 0.f, 0.f};
#pragma unroll
    for (int ks = 0; ks < 4; ++ks) {
        if (ks >= ks_lo && ks < ks_hi) {
            const bf16x8 wg = *(const bf16x8*)(WGp + (size_t)(16 * wave + fr) * 128 + 32 * ks + 8 * fq);
#pragma unroll
            for (int c = 0; c < 8; ++c) { const bf16x8 vt = *(const LAS bf16x8*)(Vt + (16 * c + fr) * VT_STRIDE + 32 * ks + 8 * fq);
                acc[c] = __builtin_amdgcn_mfma_f32_16x16x32_bf16(vt, wg, acc[c], 0, 0, 0); }
        }
    }
    {
        const int i = 16 * wave + fr, row = row0 + i;
        const float bias = a.in[12][(size_t)(e * 4 + h) * 128 + (kind ? (i & 31) : i)];
#pragma unroll
        for (int c = 0; c < 8; ++c) { const int cc = 16 * c + 4 * fq; const f32x4 g4 = *(const f32x4*)(gain + cc);
            const u32x2 up = upre[c];
            const f32x4 ug = gelu4((f32x4){bflo(up.x), bfhi(up.x), bflo(up.y), bfhi(up.y)});
            const float o0 = ug.x * (acc[c][0] * g4.x + bias), o1 = ug.y * (acc[c][1] * g4.y + bias), o2 = ug.z * (acc[c][2] * g4.z + bias), o3 = ug.w * (acc[c][3] * g4.w + bias);
            *(u32x2*)(CAT + (size_t)row * 1024 + h * 128 + cc) = (u32x2){cvt_pk_bf16(o0, o1), cvt_pk_bf16(o2, o3)}; }
    }
    __syncthreads();
}
constexpr int XC_STRIDE = 68;
__device__ __forceinline__ void gates_item(const Args& a, int e, int tile64, LAS unsigned char* lds, int wave, int lane) {
    const int h = wave, c = 64 * h + lane, row0 = tile64 * 64, fr = lane & 15, fq = lane >> 4;
    const bf16_t* XB = (const bf16_t*)(a.ws + WS_RA + MT);
    unsigned* LB = (unsigned*)(a.ws + WS_RA + 2 * MT);
    LAS float* xcs = (LAS float*)(lds + wave * (64 * XC_STRIDE * 4));
    const float* cw = a.in[13] + (size_t)e * 4 * 512;
    const float w0 = cw[c], w1 = cw[512 + c], w2 = cw[1024 + c], w3 = cw[1536 + c], cb = a.in[14][e * 512 + c];
    float x0 = 0.f, x1 = 0.f, x2 = 0.f;
    {
        bf16_t xr[64];
#pragma unroll
        for (int i = 0; i < 64; ++i) xr[i] = __builtin_nontemporal_load(XB + (size_t)(row0 + i) * 512 + c);
        const int pos0 = (row0 < MP) ? (row0 & 8191) : ((row0 - MP) & 31);
        if (pos0 != 0) { x0 = bf2f(XB[(size_t)(row0 - 3) * 512 + c]); x1 = bf2f(XB[(size_t)(row0 - 2) * 512 + c]); x2 = bf2f(XB[(size_t)(row0 - 1) * 512 + c]); }
#pragma unroll
        for (int i = 0; i < 64; ++i) {
            if ((i & 31) == 0) {
                const int rowb = row0 + i, posb = (rowb < MP) ? (rowb & 8191) : ((rowb - MP) & 31);
                if (posb == 0) {
                    if (rowb < MP) { x0 = 0.f; x1 = 0.f; x2 = 0.f; }
                    else { const float* cbuf = a.in[2] + ((size_t)(e * 32 + ((rowb - MP) >> 5)) * 3) * 512 + c; x0 = cbuf[0]; x1 = cbuf[512]; x2 = cbuf[1024]; } } }
            const float xt = bf2f(xr[i]);
            xcs[i * XC_STRIDE + lane] = w0 * x0 + w1 * x1 + w2 * x2 + w3 * xt + cb;
            x0 = x1; x1 = x2; x2 = xt; }
    }
    LDS_WAIT();
    const bf16_t* GWA = (const bf16_t*)(a.ws + WS_GWA) + (size_t)(e * 8 + h) * 64 * 64; const bf16_t* GWX = (const bf16_t*)(a.ws + WS_GWX) + (size_t)(e * 8 + h) * 64 * 64;
    bf16x8 wa[4][2], wx[4][2];
#pragma unroll
    for (int n = 0; n < 4; ++n)
#pragma unroll
        for (int ks = 0; ks < 2; ++ks) { wa[n][ks] = *(const bf16x8*)(GWA + (16 * n + fr) * 64 + 32 * ks + 8 * fq); wx[n][ks] = *(const bf16x8*)(GWX + (16 * n + fr) * 64 + 32 * ks + 8 * fq); }
    const float* BA = (const float*)(a.ws + WS_BAS) + e * 512 + 64 * h; const float* BX_ = (const float*)(a.ws + WS_BXS) + e * 512 + 64 * h; const float* SP = (const float*)(a.ws + WS_SP) + e * 512 + 64 * h;
    for (int g = 0; g < 4; ++g) {
        bf16x8 xb[2];
#pragma unroll
        for (int ks = 0; ks < 2; ++ks) { const LAS float* p = xcs + (16 * g + fr) * XC_STRIDE + 32 * ks + 8 * fq; const f32x4 lo = *(const LAS f32x4*)p, hi = *(const LAS f32x4*)(p + 4);
            xb[ks] = __builtin_bit_cast(bf16x8, pack8(lo, hi)); }
        f32x4 aa[4], ax[4];
#pragma unroll
        for (int n = 0; n < 4; ++n) { aa[n] = (f32x4){0.f, 0.f, 0.f, 0.f}; ax[n] = (f32x4){0.f, 0.f, 0.f, 0.f};
#pragma unroll
            for (int ks = 0; ks < 2; ++ks) { aa[n] = __builtin_amdgcn_mfma_f32_16x16x32_bf16(wa[n][ks], xb[ks], aa[n], 0, 0, 0); ax[n] = __builtin_amdgcn_mfma_f32_16x16x32_bf16(wx[n][ks], xb[ks], ax[n], 0, 0, 0); } }
        u32x4 pk[4];
#pragma unroll
        for (int n = 0; n < 4; ++n) { const int cc = 16 * n + 4 * fq;
            const f32x4 xc4 = *(const LAS f32x4*)(xcs + (16 * g + fr) * XC_STRIDE + cc), ba4 = *(const f32x4*)(BA + cc), bx4 = *(const f32x4*)(BX_ + cc), sp4 = *(const f32x4*)(SP + cc);
            f32x4 la, bb;
#pragma unroll
            for (int r = 0; r < 4; ++r) { const float rg = __builtin_amdgcn_rcpf(1.0f + __builtin_amdgcn_exp2f(aa[n][r] + ba4[r])), ig = __builtin_amdgcn_rcpf(1.0f + __builtin_amdgcn_exp2f(ax[n][r] + bx4[r])); const float l = rg * sp4[r];
                const float w = (l > -0.03125f) ? -l * (1.0f + l * (0.5f + l * (0.16666667f + l * 0.041666668f))) : 1.0f - exp_f(l);
                const float om = w * (2.0f - w);
                la[r] = w; bb[r] = __builtin_amdgcn_sqrtf(fmaxf(om, 0.f)) * ig * xc4[r]; }
            pk[n] = (u32x4){cvt_pk_bf16(la[0], bb[0]), cvt_pk_bf16(la[1], bb[1]), cvt_pk_bf16(la[2], bb[2]), cvt_pk_bf16(la[3], bb[3])}; }
        LDS_WAIT();
#pragma unroll
        for (int n = 0; n < 4; ++n) *(LAS u32x4*)((LAS unsigned*)xcs + (16 * g + fr) * XC_STRIDE + 16 * n + 4 * fq) = pk[n];
    }
    LDS_WAIT();
    {
        float* AGGA = (float*)(a.ws + WS_AGGA); float* AGGB = (float*)(a.ws + WS_AGGB);
        float sa = 1.f, hh = 0.f;
#pragma unroll 8
        for (int t = 0; t < 64; ++t) { const unsigned p = ((const LAS unsigned*)xcs)[t * XC_STRIDE + lane]; LB[(size_t)(row0 + t) * 512 + c] = p;
            const float a_ = 1.0f - bflo(p); sa *= a_; hh = a_ * hh + bfhi(p);
            if ((t & 31) == 31) { const size_t ai = (size_t)((row0 >> 5) + (t >> 5)) * 512 + c; AGGA[ai] = sa; AGGB[ai] = hh; sa = 1.f; hh = 0.f; } }
    }
    LDS_WAIT();
}
__device__ __forceinline__ void phase_scan_agg(const Args& a, int gt, int GT) {
    const unsigned* LB = (const unsigned*)(a.ws + WS_RA + 2 * MT);
    float* AGGA = (float*)(a.ws + WS_AGGA); float* AGGB = (float*)(a.ws + WS_AGGB);
    for (int idx = gt; idx < NCH32 * 512; idx += GT) { const int ch = idx >> 9, c = idx & 511; const size_t base = (size_t)ch * 32 * 512 + c;
        float sl = 0.f, hh = 0.f;
#pragma unroll 8
        for (int t = 0; t < 32; ++t) { const unsigned p = LB[base + (size_t)t * 512]; const float l = bflo(p), b = bfhi(p); sl += l; hh = exp_f(l) * hh + b; }
        AGGA[idx] = sl; AGGB[idx] = hh; }
}
__device__ __forceinline__ void phase_scan_carry(const Args& a, int gw, int NGW, int lane) {
    const float* AGGA = (const float*)(a.ws + WS_AGGA); const float* AGGB = (const float*)(a.ws + WS_AGGB); float* CARRY = (float*)(a.ws + WS_CARRY);
    for (int task = gw; task < 1024; task += NGW) { const int b = task >> 9, c = task & 511; const size_t base = (size_t)(b * 256 + 4 * lane) * 512 + c;
        float ak[4], bk[4];
#pragma unroll
        for (int k = 0; k < 4; ++k) { ak[k] = AGGA[base + (size_t)k * 512]; bk[k] = AGGB[base + (size_t)k * 512]; }
        float ea[4], eb[4]; float A = 1.f, B = 0.f;
#pragma unroll
        for (int k = 0; k < 4; ++k) { ea[k] = A; eb[k] = B; B = ak[k] * B + bk[k]; A = ak[k] * A; }
#pragma unroll
        for (int d = 1; d < 64; d <<= 1) { const float pa = __shfl_up(A, d), pb = __shfl_up(B, d); if (lane >= d) { B = A * pb + B; A = A * pa; } }
        float Pb = __shfl_up(B, 1); if (lane == 0) Pb = 0.f;
#pragma unroll
        for (int k = 0; k < 4; ++k) CARRY[base + (size_t)k * 512] = ea[k] * Pb + eb[k];
    }
}
__device__ __forceinline__ void phase_scan_apply(const Args& a, int e, float* out_bconv_p, float* out_bh_p, float* out_bconv_s, float* out_bh_s, int gt, int GT) {
    const unsigned* LB = (const unsigned*)(a.ws + WS_RA + 2 * MT);
    const bf16_t* XB = (const bf16_t*)(a.ws + WS_RA + MT); const bf16_t* GG = (const bf16_t*)(a.ws + WS_RA + MT + MT / 2);
    const float* CARRY = (const float*)(a.ws + WS_CARRY);
    bf16_t* CAT = (bf16_t*)(a.ws + WS_BX);
    for (int idx = gt; idx < NCH32 * 512; idx += GT) { const int ch = idx >> 9, c = idx & 511; const size_t base = (size_t)ch * 32 * 512 + c;
        float hh;
        if (ch < 512) hh = CARRY[idx];
        else hh = a.in[3][(size_t)(e * 32 + (ch - 512)) * 512 + c];
        unsigned pw[32]; bf16_t gg[32];
#pragma unroll
        for (int t = 0; t < 32; ++t) { pw[t] = __builtin_nontemporal_load(LB + base + (size_t)t * 512); gg[t] = __builtin_nontemporal_load(GG + base + (size_t)t * 512); }
#pragma unroll
        for (int t = 0; t < 32; ++t) { const float a_ = 1.0f - bflo(pw[t]), b = bfhi(pw[t]); hh = a_ * hh + b;
            CAT[((size_t)ch * 32 + t) * 1024 + 512 + c] = f2bf(hh * bf2f(gg[t])); }
        const bool last = (ch >= 512) || ((ch & 255) == 255);
        if (last) { const size_t r0 = (size_t)ch * 32 + 29;
            if (ch < 512) { const int b = ch >> 8; out_bh_p[(e * 2 + b) * 512 + c] = hh;
#pragma unroll
                for (int j = 0; j < 3; ++j) out_bconv_p[((size_t)(e * 2 + b) * 3 + j) * 512 + c] = bf2f(XB[(r0 + j) * 512 + c]); }
            else { const int s = ch - 512; out_bh_s[(e * 32 + s) * 512 + c] = hh;
#pragma unroll
                for (int j = 0; j < 3; ++j) out_bconv_s[((size_t)(e * 32 + s) * 3 + j) * 512 + c] = bf2f(XB[(r0 + j) * 512 + c]); } }
    }
}
__device__ __forceinline__ void phase_conv_odd(const Args& a, int o, float* out_cc_p, float* out_cc_s, int gt, int GT) {
    const bf16_t* BG = (const bf16_t*)(a.ws + WS_RA); const bf16_t* T = (const bf16_t*)(a.ws + WS_RA + MT); bf16_t* A2 = (bf16_t*)(a.ws + WS_BX);
    const float* cw = a.in[22] + (size_t)o * 3 * 1024;
    constexpr int RB = 4;
    for (int idx = gt; idx < (M / RB) * 128; idx += GT) { const int rb = idx >> 7, c0 = (idx & 127) * 8, row0 = rb * RB; const int pos0 = (row0 < MP) ? (row0 & 8191) : ((row0 - MP) & 31);
        u32x4 tb[RB], bgb[RB];
#pragma unroll
        for (int i = 0; i < RB; ++i) { tb[i] = *(const u32x4*)(T + (size_t)(row0 + i) * 1024 + c0); bgb[i] = __builtin_nontemporal_load((const u32x4*)(BG + (size_t)(row0 + i) * 1024 + c0)); }
        float t1[8], t2[8];
        if (pos0 != 0) { unpack8(*(const u32x4*)(T + (size_t)(row0 - 1) * 1024 + c0), t1); unpack8(*(const u32x4*)(T + (size_t)(row0 - 2) * 1024 + c0), t2); }
        else if (row0 < MP) {
#pragma unroll
            for (int r = 0; r < 8; ++r) { t1[r] = 0.f; t2[r] = 0.f; } }
        else { const float* cbuf = a.in[4] + ((size_t)(o * 32 + ((row0 - MP) >> 5)) * 2) * 1024 + c0;
#pragma unroll
            for (int r = 0; r < 8; ++r) { t2[r] = cbuf[r]; t1[r] = cbuf[1024 + r]; } }
        float w0[8], w1[8], w2[8];
#pragma unroll
        for (int r = 0; r < 8; ++r) { w0[r] = cw[c0 + r]; w1[r] = cw[1024 + c0 + r]; w2[r] = cw[2048 + c0 + r]; }
#pragma unroll
        for (int i = 0; i < RB; ++i) { float t0[8], g[8], y[8]; unpack8(tb[i], t0); unpack8(bgb[i], g);
#pragma unroll
            for (int r = 0; r < 8; ++r) y[r] = g[r] * (w0[r] * t2[r] + w1[r] * t1[r] + w2[r] * t0[r]);
            *(u32x4*)(A2 + (size_t)(row0 + i) * 1024 + c0) = (u32x4){cvt_pk_bf16(y[0], y[1]), cvt_pk_bf16(y[2], y[3]), cvt_pk_bf16(y[4], y[5]), cvt_pk_bf16(y[6], y[7])};
#pragma unroll
            for (int r = 0; r < 8; ++r) { t2[r] = t1[r]; t1[r] = t0[r]; } }
        const int posl = pos0 + RB - 1;
        if (row0 < MP) { if (posl == 8191) { float* dst = out_cc_p + ((size_t)(o * 2 + (row0 >> 13)) * 2) * 1024 + c0;
#pragma unroll
                for (int r = 0; r < 8; ++r) { dst[r] = t2[r]; dst[1024 + r] = t1[r]; } } }
        else if (posl == 31) { float* dst = out_cc_s + ((size_t)(o * 32 + ((row0 - MP) >> 5)) * 2) * 1024 + c0;
#pragma unroll
            for (int r = 0; r < 8; ++r) { dst[r] = t2[r]; dst[1024 + r] = t1[r]; } }
    }
}

#define XB_TMO      128
#define XB_XCNT(j)  (256  + 64 * (j))
#define XB_XSUB(j)  (1280 + 64 * (j))
#define XB_XGEN(j)  (2304 + 64 * (j))
#define XB_TOP      3328
#define XB_TOPGEN   3392
#define XCD_BAR_WORDS 3456
#define XB_SPIN_CAP (1u << 18)

__device__ __forceinline__ unsigned xb_ld(unsigned* p)              { return __hip_atomic_load(p, __ATOMIC_RELAXED, __HIP_MEMORY_SCOPE_AGENT); }
__device__ __forceinline__ unsigned xb_add(unsigned* p, unsigned v) { return __hip_atomic_fetch_add(p, v, __ATOMIC_RELAXED, __HIP_MEMORY_SCOPE_AGENT); }
__device__ __forceinline__ unsigned xb_xcc_id() { return (unsigned)__builtin_amdgcn_s_getreg((3 << 11) | 20) & 0xFu; }
#define XB_SPIN(cond, bar) do { unsigned _sp = 0; while (cond) { __builtin_amdgcn_s_sleep(1); \
    if ((++_sp & 255u) == 0u) { if (xb_ld(&(bar)[XB_TMO])) break; if (_sp > XB_SPIN_CAP) { atomicAdd(&(bar)[XB_TMO], 1u); break; } } } } while (0)

struct XcdBarrier {
    unsigned* bar; unsigned x;
    volatile LAS unsigned* st;
};

__device__ __forceinline__ XcdBarrier xcd_barrier_post(unsigned* bar, volatile LAS unsigned* st) {
    XcdBarrier b; b.bar = bar; b.x = xb_xcc_id(); b.st = st;
    if (threadIdx.x == 0) (void)xb_add(&bar[XB_XCNT(b.x)], 1u);
    return b;
}
__device__ __forceinline__ void xcd_barrier_complete(unsigned* bar, unsigned x, unsigned& nloc, unsigned& nx) {
    const unsigned G = gridDim.x * gridDim.y * gridDim.z;
    unsigned sum, cnt, mine, sp = 0u;
    for (;;) {
        sum = 0u; cnt = 0u; mine = 0u;
#pragma unroll
        for (unsigned j = 0; j < 16; ++j) { const unsigned c = xb_ld(&bar[XB_XCNT(j)]); sum += c; cnt += (c > 0u) ? 1u : 0u; mine = (j == x) ? c : mine; }
        if (sum == G) break;
        __builtin_amdgcn_s_sleep(1);
        if ((++sp & 255u) == 0u) { if (xb_ld(&bar[XB_TMO])) break; if (sp > XB_SPIN_CAP) { atomicAdd(&bar[XB_TMO], 1u); break; } }
    }
    nloc = mine > 0u ? mine : 1u; nx = cnt > 0u ? cnt : 1u;
}

__device__ __forceinline__ void xcd_barrier(const XcdBarrier& b) {
    asm volatile("s_waitcnt vmcnt(0)" ::: "memory");
    __syncthreads();
    if (threadIdx.x == 0) {
        unsigned* bar = b.bar;
        __builtin_amdgcn_s_waitcnt(0);
        unsigned nloc = b.st[0], nx = b.st[1];
        if (nloc == 0u) { xcd_barrier_complete(bar, b.x, nloc, nx); b.st[0] = nloc; b.st[1] = nx; }
        const unsigned old = xb_add(&bar[XB_XSUB(b.x)], 1u);
        const unsigned gen = old / nloc;
        if (old + 1u == (gen + 1u) * nloc) {
            __builtin_amdgcn_fence(__ATOMIC_RELEASE, "agent");
            asm volatile("s_waitcnt vmcnt(0)" ::: "memory");
            const unsigned og = xb_add(&bar[XB_TOP], 1u);
            const unsigned tg = og / nx;
            if (og + 1u == (tg + 1u) * nx) xb_add(&bar[XB_TOPGEN], 1u);
            else XB_SPIN(xb_ld(&bar[XB_TOPGEN]) == tg, bar);
            __builtin_amdgcn_fence(__ATOMIC_ACQUIRE, "agent");
            xb_add(&bar[XB_XGEN(b.x)], 1u);
            asm volatile("s_waitcnt vmcnt(0)" ::: "memory");
        } else {
            XB_SPIN(xb_ld(&bar[XB_XGEN(b.x)]) == gen, bar);
            __builtin_amdgcn_fence(__ATOMIC_ACQUIRE, "agent");
            asm volatile("s_waitcnt vmcnt(0)" ::: "memory");
        }
    }
    __syncthreads();
}
__global__ void __launch_bounds__(512, 2) fwd_megakernel(Args a) {
    extern __shared__ __attribute__((aligned(16))) unsigned char lds_raw[];
    LAS unsigned char* lds = (LAS unsigned char*)lds_raw;
    cg::grid_group grid = cg::this_grid();
    const int G = gridDim.x, NGW = G * 8, GT = G * 512;
    volatile LAS unsigned* bst = (volatile LAS unsigned*)(lds + LDS_BYTES - 16);
    if (threadIdx.x < 2) bst[threadIdx.x] = 0u;
    __syncthreads();
    const XcdBarrier xbar = xcd_barrier_post((unsigned*)(a.ws + WS_BAR), bst);
    for (int ph = a.ph_lo; ph < a.ph_hi; ++ph) {
        bool ran = true;
        int tid = threadIdx.x; asm volatile("" : "+v"(tid));
        int oz = 0; asm volatile("" : "+s"(oz));
        const int lane = tid & 63, wave = __builtin_amdgcn_readfirstlane(tid >> 6), gw = blockIdx.x * 8 + wave, gt = blockIdx.x * 512 + tid;
    unsigned char* ws = a.ws + oz;
    float* X = a.out + oz;
    float* out_vs = X + (size_t)M * D;
    float* out_bconv_p = out_vs + 2 * 32 * 32 * 512;
    float* out_bh_p = out_bconv_p + 2 * 2 * 3 * 512;
    float* out_cc_p = out_bh_p + 2 * 2 * 512;
    float* out_bconv_s = out_cc_p + 2 * 2 * 2 * 1024;
    float* out_bh_s = out_bconv_s + 2 * 32 * 3 * 512;
    float* out_cc_s = out_bh_s + 2 * 32 * 512;
    bf16_t* HN = (bf16_t*)(ws + WS_HN); bf16_t* BXb = (bf16_t*)(ws + WS_BX); bf16_t* RA = (bf16_t*)(ws + WS_RA);

        if (ph == 0) {
 for (int rp = 0; rp < (PROBE == 7 ? 2 : 1); ++rp) { phase_prologue(a, lds, gw, NGW, wave, lane); if (PROBE == 7) __syncthreads(); }
}
        else {
            const int l = (ph - 1) / 10, s = (ph - 1) % 10; const bool even = !(l & 1); const int e = l >> 1;
            if (s == 0 || s == 5 || s == 7 || s == 8) {
                const bf16_t* gA; const bf16_t* gB; int gN, gK, emode, eldc; bf16_t* eO0; bf16_t* eP1 = (bf16_t*)(ws + WS_RA + MT);
                if (s == 0) { gA = HN; gB = (const bf16_t*)(ws + WS_WIN); gN = even ? 2048 : 3072; gK = 1024; eO0 = RA;
                    if (even) { emode = 2; eldc = 512; }
                    else { emode = 3; eldc = 1024; } }
                else if (s == 5) { gA = BXb; gB = (const bf16_t*)(ws + WS_WOUT); gN = 1024; gK = 1024; emode = 0; eO0 = RA; eldc = 1024; }
                else if (s == 7) { gA = HN; gB = (const bf16_t*)(ws + WS_WUP); gN = 4096; gK = 1024; emode = 1; eO0 = RA; eldc = 4096; }
                else { gA = RA; gB = (const bf16_t*)(ws + WS_WDN); gN = 1024; gK = 4096; emode = 0; eO0 = BXb; eldc = 1024; }
                const pg8::Gemm g{gA, gB, M, gN, gK};
                const pg8::EpiMulti E{emode, eO0, eldc, eP1, (float*)(ws + WS_VSS), (bf16_t*)(ws + WS_PART), (const float*)(ws + WS_RSTD)};
                pg8::SplitOrder S; S.init(gN, gK, G, (int)blockIdx.x, s == 5 ? 4 : (s == 8 ? 8 : 1));
                for (int rp = 0; rp < ((PROBE == 6 || (PROBE == 60 && s == 0) || (PROBE == 65 && s == 5) || (PROBE == 67 && s == 7) || (PROBE == 68 && s == 8)) ? 2 : 1); ++rp) pg8::gemm_phase<pg8::EpiMulti, pg8::SplitOrder, true, true>(lds, g, S, E);
                const int bx = (int)blockIdx.x;
                if (s == 7 && l < 3 && bx >= 64) convert_weights(a, l + 1, 3, lds, (bx - 64) * 8 + wave, (G - 64) * 8, wave, lane);
                else if (s == 8 && l < 3 && bx >= 128) convert_weights(a, l + 1, 4, lds, (bx - 128) * 8 + wave, (G - 128) * 8, wave, lane);
                else if (s == 0 && bx >= 48) convert_weights(a, l, l == 0 ? 14 : 8, lds, (bx - 48) * 8 + wave, (G - 48) * 8, wave, lane);
            } else if (s == 1) {
                if (even) {
                    for (int rp = 0; rp < (PROBE == 2 ? 2 : 1); ++rp)
                    { float* vso = out_vs + (size_t)e * 32 * 32 * 512;
                    if (G == 256) {
                        const int bx = (int)blockIdx.x; int g0, gn, t0, tn;
                        if (bx < 48) { g0 = 4 * bx; gn = 4; t0 = 0; tn = 0; }
                        else if (bx < 192) { g0 = 192 + 2 * (bx - 48); gn = 2; t0 = bx - 48; tn = 1; }
                        else { g0 = 480 + (bx - 192); gn = 1; t0 = 144 + 2 * (bx - 192); tn = 2; }
                        for (int i = 0; i < gn; ++i) gating_item(a, e, g0 + i, vso, lds, tid, wave, lane);
                        for (int i = 0; i < tn; ++i) gates_item(a, e, t0 + i, lds, wave, lane);
                    } else {
                    for (int it = blockIdx.x; it < 544 + 272; it += G) {
                        if (it < 544) gating_item(a, e, it, vso, lds, tid, wave, lane);
                        if (it >= 544) gates_item(a, e, it - 544, lds, wave, lane);
                    } } }
                } else { for (int rp = 0; rp < (PROBE == 5 ? 2 : 1); ++rp) phase_conv_odd(a, e, out_cc_p, out_cc_s, gt, GT); }
            } else if (s == 2) { ran = false; }
            else if (s == 3) { if (even) phase_scan_carry(a, gw, NGW, lane); else ran = false; }
            else if (s == 4) { if (even) { for (int rp = 0; rp < (PROBE == 4 ? 2 : 1); ++rp) phase_scan_apply(a, e, out_bconv_p, out_bh_p, out_bconv_s, out_bh_s, gt, GT); } else ran = false; }
            else if (s == 6) phase_rows(a.in[6] + l * 1024, RA, (const bf16_t*)(ws + WS_PART), 4, HN, (float*)(ws + WS_RSTD), nullptr, gw, NGW, lane);
            else {
                phase_rows(a.in[8] + l * 1024, BXb, (const bf16_t*)(ws + WS_PART), 8, HN, (float*)(ws + WS_RSTD), l < 3 ? nullptr : X, gw, NGW, lane);
            }
        }
        if (ran && ph + 1 < a.ph_hi) { if (a.ph_hi < 0) grid.sync(); else xcd_barrier(xbar); if (PROBE == 1) xcd_barrier(xbar); }
    }
}

extern "C" void kernel_launch(void* const* d_in, const int* in_sizes, int n_in, void* d_out, int out_size, void* d_ws, size_t ws_size, hipStream_t stream) {
    static int grid = 0;
    if (grid == 0) {
        int dev = 0, cus = 0, per_cu = 0;
        if (hipGetDevice(&dev) != hipSuccess || hipDeviceGetAttribute(&cus, hipDeviceAttributeMultiprocessorCount, dev) != hipSuccess) { fprintf(stderr, "kernel_launch: device query failed\n"); grid = -1; return; }
        if (hipFuncSetAttribute((const void*)fwd_megakernel, hipFuncAttributeMaxDynamicSharedMemorySize, LDS_BYTES) != hipSuccess) { fprintf(stderr, "kernel_launch: hipFuncSetAttribute failed\n"); grid = -1; return; }
        if (hipOccupancyMaxActiveBlocksPerMultiprocessor(&per_cu, (const void*)fwd_megakernel, 512, LDS_BYTES) != hipSuccess || per_cu < 1) { fprintf(stderr, "kernel_launch: occupancy query says %d\n", per_cu); per_cu = 1; }
        (void)hipGetLastError();
        if (n_in != 26 || ws_size < WS_CARRY + 1 * MiB) { fprintf(stderr, "kernel_launch: unexpected n_in %d / ws_size %zu (need %zu)\n", n_in, ws_size, (size_t)(WS_CARRY + 1 * MiB)); grid = -1; return; }
        grid = cus;
    }
    if (grid < 0) return;
    Args a{};
    for (int i = 0; i < 26; ++i) a.in[i] = (const float*)d_in[i];
    a.out = (float*)d_out; a.ws = (unsigned char*)d_ws; a.ph_lo = 0; a.ph_hi = 41;
    if (hipMemsetAsync((char*)d_ws + WS_BAR, 0, XCD_BAR_WORDS * sizeof(unsigned), stream) != hipSuccess) { fprintf(stderr, "kernel_launch: memset of barrier words failed\n"); return; }
    void* args[] = {&a};
    hipError_t e = hipLaunchCooperativeKernel((const void*)fwd_megakernel, dim3(grid), dim3(512), args, LDS_BYTES, stream);
    if (e != hipSuccess) fprintf(stderr, "kernel_launch: cooperative launch failed: %s (grid %d)\n", hipGetErrorString(e), grid);
}
```
